# Optimizing an MI355X kernel written in HIP

```python
import jax
import jax.numpy as jnp
from jax import lax
import numpy as np


D_MODEL = 2048
BATCH = 4
SEQ = 2048
DEPTH = 1

CHUNK = 64
SPATIAL_BLOCK = 128
A_WIDTH = D_MODEL
A_GROUPS = 8
A_GROUP_DIM = A_WIDTH // A_GROUPS
GLA_HEADS = 4
GLA_DK = D_MODEL // 2
GLA_DV = D_MODEL
GLA_HEAD_K = GLA_DK // GLA_HEADS
GLA_HEAD_V = GLA_DV // GLA_HEADS
GLA_GATE_RANK = 16
GLA_GATE_TAU = 16.0
N_EXPERTS = 32
TOP_K = 4
D_FF = D_MODEL
SWIGLU_LIMIT = 7.0
SWIGLU_ALPHA = 1.702
EXPERT_BLOCK = 256
NORM_EPS = 1e-6
IN_SPLITS = (A_WIDTH, A_WIDTH, GLA_DK, GLA_DK, GLA_DV, GLA_DV, GLA_GATE_RANK, D_MODEL, D_MODEL)
IN_WIDTH = 2 * A_WIDTH + 2 * GLA_DK + 2 * GLA_DV + GLA_GATE_RANK + 2 * D_MODEL

kernel_name = 'hybrid_gmlp_gla_moe_adaln_block'


def _split_points():
    pts, acc = [], 0
    for w in IN_SPLITS[:-1]:
        acc += w
        pts.append(acc)
    return pts


def rms_norm(x, g):
    xf = x.astype(jnp.float32)
    y = xf * lax.rsqrt(jnp.mean(xf * xf, axis=-1, keepdims=True) + NORM_EPS)
    return (y * g.astype(jnp.float32)).astype(x.dtype)


def layer_norm(x, g, b):
    xf = x.astype(jnp.float32)
    mu = jnp.mean(xf, axis=-1, keepdims=True)
    xc = xf - mu
    var = jnp.mean(xc * xc, axis=-1, keepdims=True)
    return (xc * lax.rsqrt(var + NORM_EPS) * g.astype(jnp.float32) + b.astype(jnp.float32)).astype(x.dtype)


def spatial_gating(u, v, ln_g, ln_b, w_s, b_s):
    B, S, _ = v.shape
    nb = S // SPATIAL_BLOCK
    vn = layer_norm(v, ln_g, ln_b).reshape(B, nb, SPATIAL_BLOCK, A_GROUPS, A_GROUP_DIM)
    chunk_id = jnp.arange(SPATIAL_BLOCK) // CHUNK
    mask = chunk_id[None, :] <= chunk_id[:, None]
    w = jnp.where(mask[None], w_s, 0.0)
    mixed = jnp.einsum('gts,bnsgc->bntgc', w, vn) + b_s.T[None, None, :, :, None]
    return u * mixed.reshape(B, S, A_WIDTH)


def gated_linear_attention(q, k, v, log_a):
    B, S, H, dk = q.shape
    dv = v.shape[-1]
    n = S // CHUNK
    f32 = jnp.float32
    q = q.astype(f32).reshape(B, n, CHUNK, H, dk) * (dk ** -0.5)
    k = k.astype(f32).reshape(B, n, CHUNK, H, dk)
    v = v.astype(f32).reshape(B, n, CHUNK, H, dv)
    b = jnp.cumsum(log_a.astype(f32).reshape(B, n, CHUNK, H, dk), axis=2)
    b_last = b[:, :, -1:]
    q_dec = q * jnp.exp(b)
    k_intra = k * jnp.exp(-b)
    k_state = k * jnp.exp(b_last - b)
    causal = jnp.tril(jnp.ones((CHUNK, CHUNK), dtype=bool))
    att = jnp.einsum('bnthk,bnshk->bnhts', q_dec, k_intra)
    att = jnp.where(causal, att, 0.0)
    o_intra = jnp.einsum('bnhts,bnshv->bnthv', att, v)

    def step(state, inp):
        qc, kc, vc, dc = inp
        o = jnp.einsum('blhk,bhkv->blhv', qc, state)
        state = dc[..., None] * state + jnp.einsum('blhk,blhv->bhkv', kc, vc)
        return state, o

    xs = (jnp.moveaxis(q_dec, 1, 0), jnp.moveaxis(k_state, 1, 0), jnp.moveaxis(v, 1, 0),
          jnp.moveaxis(jnp.exp(b_last[:, :, 0]), 1, 0))
    s0 = jnp.zeros((B, H, dk, dv), f32)
    _, o_inter = lax.scan(step, s0, xs)
    o = o_intra + jnp.moveaxis(o_inter, 0, 1)
    return o.reshape(B, S, H, dv)


def routed_experts(h, router_w, router_b, w_gate, b_gate, w_up, b_up, w_down, b_down):
    B, S, D = h.shape
    T = B * S
    n_rows = T * TOP_K
    n_blocks = (n_rows + N_EXPERTS * (EXPERT_BLOCK - 1) + EXPERT_BLOCK - 1) // EXPERT_BLOCK
    hf = h.reshape(T, D)
    logits = (hf @ router_w + router_b).astype(jnp.float32)
    top_logit, top_idx = lax.top_k(logits, TOP_K)
    top_w = jax.nn.softmax(top_logit, axis=-1)
    flat_e = top_idx.reshape(n_rows)
    flat_tok = jnp.repeat(jnp.arange(T, dtype=jnp.int32), TOP_K)
    flat_w = top_w.reshape(n_rows)
    order = jnp.argsort(flat_e)
    sorted_e = flat_e[order]
    counts = jnp.bincount(flat_e, length=N_EXPERTS)
    starts = jnp.cumsum(counts) - counts
    padded = (counts + EXPERT_BLOCK - 1) // EXPERT_BLOCK * EXPERT_BLOCK
    padded_end = jnp.cumsum(padded)
    padded_start = padded_end - padded
    dest = padded_start[sorted_e] + jnp.arange(n_rows) - starts[sorted_e]
    row_tok = jnp.zeros((n_blocks * EXPERT_BLOCK,), jnp.int32).at[dest].set(flat_tok[order])
    row_w = jnp.zeros((n_blocks * EXPERT_BLOCK,), jnp.float32).at[dest].set(flat_w[order])
    block_e = jnp.minimum(jnp.searchsorted(padded_end, jnp.arange(n_blocks) * EXPERT_BLOCK, side='right'),
                          N_EXPERTS - 1)

    def step(acc, inp):
        e, tok, w = inp
        xb = hf[tok]
        g = jnp.minimum(xb @ w_gate[e] + b_gate[e], SWIGLU_LIMIT)
        u = jnp.clip(xb @ w_up[e] + b_up[e], -SWIGLU_LIMIT, SWIGLU_LIMIT)
        y = ((u + 1.0) * (g * jax.nn.sigmoid(SWIGLU_ALPHA * g))) @ w_down[e] + b_down[e]
        return acc.at[tok].add(y.astype(jnp.float32) * w[:, None]), None

    acc, _ = lax.scan(step, jnp.zeros((T, D), jnp.float32),
                      (block_e, row_tok.reshape(n_blocks, EXPERT_BLOCK), row_w.reshape(n_blocks, EXPERT_BLOCK)))
    return acc.reshape(B, S, D).astype(h.dtype)


def setup_inputs(seed: int = 0) -> dict:
    key = jax.random.key(seed)
    ks = jax.random.split(key, 26)
    f32 = jnp.float32
    L, D = DEPTH, D_MODEL

    def nrm(k, shape, scale):
        return jax.random.normal(k, shape, f32) * scale

    return {
        'x': nrm(ks[0], (BATCH, SEQ, D), 1.0),
        'c': nrm(ks[1], (BATCH, D), 1.0),
        'ada_w': nrm(ks[2], (L, D, 6 * D), 0.5 * D ** -0.5),
        'ada_b': nrm(ks[3], (L, 6 * D), 0.02),
        'norm1_g': 1.0 + nrm(ks[4], (L, D), 0.02),
        'w_in': nrm(ks[5], (L, D, IN_WIDTH), D ** -0.5),
        'gla_gate_w2': nrm(ks[6], (L, GLA_GATE_RANK, GLA_DK), GLA_GATE_RANK ** -0.5),
        'gla_gate_b': nrm(ks[7], (L, GLA_DK), 0.1),
        'sgu_ln_g': 1.0 + nrm(ks[8], (L, A_WIDTH), 0.02),
        'sgu_ln_b': nrm(ks[9], (L, A_WIDTH), 0.02),
        'sgu_w': nrm(ks[10], (L, A_GROUPS, SPATIAL_BLOCK, SPATIAL_BLOCK), SPATIAL_BLOCK ** -0.5),
        'sgu_b': 1.0 + nrm(ks[11], (L, A_GROUPS, SPATIAL_BLOCK), 0.02),
        'gla_norm_g': 1.0 + nrm(ks[12], (L, GLA_HEAD_V), 0.02),
        'w_branch_a': nrm(ks[13], (L, A_WIDTH, D), A_WIDTH ** -0.5),
        'w_branch_b': nrm(ks[14], (L, GLA_DV, D), GLA_DV ** -0.5),
        'w_out': nrm(ks[15], (L, D, D), D ** -0.5),
        'norm2_g': 1.0 + nrm(ks[16], (L, D), 0.02),
        'router_w': nrm(ks[17], (L, D, N_EXPERTS), D ** -0.5),
        'router_b': nrm(ks[18], (L, N_EXPERTS), 0.01),
        'exp_w_gate': nrm(ks[19], (L, N_EXPERTS, D, D_FF), D ** -0.5),
        'exp_b_gate': nrm(ks[20], (L, N_EXPERTS, D_FF), 0.01),
        'exp_w_up': nrm(ks[21], (L, N_EXPERTS, D, D_FF), D ** -0.5),
        'exp_b_up': nrm(ks[22], (L, N_EXPERTS, D_FF), 0.01),
        'exp_w_down': nrm(ks[23], (L, N_EXPERTS, D_FF, D), D_FF ** -0.5),
        'exp_b_down': nrm(ks[24], (L, N_EXPERTS, D), 0.01),
        'final_g': 1.0 + nrm(ks[25], (D,), 0.02),
    }


def reference(x, c, ada_w, ada_b, norm1_g, w_in, gla_gate_w2, gla_gate_b, sgu_ln_g, sgu_ln_b, sgu_w, sgu_b,
              gla_norm_g, w_branch_a, w_branch_b, w_out, norm2_g, router_w, router_b, exp_w_gate, exp_b_gate,
              exp_w_up, exp_b_up, exp_w_down, exp_b_down, final_g):
    B, S, D = x.shape
    cond = jax.nn.silu(c)
    split_points = _split_points()
    for l in range(DEPTH):
        mod = cond @ ada_w[l] + ada_b[l]
        sh1, sc1, gt1, sh2, sc2, gt2 = [m[:, None, :] for m in jnp.split(mod, 6, axis=-1)]

        h = rms_norm(x, norm1_g[l]) * (1.0 + sc1) + sh1
        proj = h @ w_in[l]
        a_u, a_v, q, k, v, r, g_lr, gate_a, gate_b = jnp.split(proj, split_points, axis=-1)
        y_a = spatial_gating(jax.nn.gelu(a_u), jax.nn.gelu(a_v), sgu_ln_g[l], sgu_ln_b[l], sgu_w[l], sgu_b[l])
        log_a = jax.nn.log_sigmoid((g_lr @ gla_gate_w2[l] + gla_gate_b[l]).astype(jnp.float32)) / GLA_GATE_TAU
        o = gated_linear_attention(q.reshape(B, S, GLA_HEADS, GLA_HEAD_K), k.reshape(B, S, GLA_HEADS, GLA_HEAD_K),
                                   v.reshape(B, S, GLA_HEADS, GLA_HEAD_V), log_a.reshape(B, S, GLA_HEADS, GLA_HEAD_K))
        o = rms_norm(o, gla_norm_g[l]).astype(x.dtype)
        y_b = o.reshape(B, S, GLA_DV) * jax.nn.silu(r)
        merged = jax.nn.sigmoid(gate_a) * (y_a @ w_branch_a[l]) + jax.nn.sigmoid(gate_b) * (y_b @ w_branch_b[l])
        x = x + gt1 * (merged @ w_out[l])

        h2 = rms_norm(x, norm2_g[l]) * (1.0 + sc2) + sh2
        x = x + gt2 * routed_experts(h2, router_w[l], router_b[l], exp_w_gate[l], exp_b_gate[l], exp_w_up[l],
                                     exp_b_up[l], exp_w_down[l], exp_b_down[l])
    return rms_norm(x, final_g)
```

```cpp
#include <hip/hip_runtime.h>
#include <cstdio>
#include <cstdint>

#ifndef DBG_MODE
#define DBG_MODE 0
#endif
#ifndef REPEAT_MASK
#define REPEAT_MASK 0
#endif
#ifndef REP_SCAN
#define REP_SCAN 1
#endif
#ifndef REP_SG
#define REP_SG 1
#endif
#ifndef PROJ8_PN0
#define PROJ8_PN0 0
#endif
#ifndef MIX8
#define MIX8 0
#endif
#ifndef MK_N_LAUNCHES
#define MK_N_LAUNCHES 1
#endif

#define LAS __attribute__((address_space(3)))
#define GAS __attribute__((address_space(1)))
typedef unsigned short bf16_t;
typedef short bf16x8 __attribute__((ext_vector_type(8)));
typedef float f32x4 __attribute__((ext_vector_type(4)));
typedef float f32x2 __attribute__((ext_vector_type(2)));
typedef float f32x16 __attribute__((ext_vector_type(16)));
typedef unsigned u32x4 __attribute__((ext_vector_type(4)));
typedef unsigned u32x2 __attribute__((ext_vector_type(2)));
typedef int i32x4 __attribute__((ext_vector_type(4)));
typedef int i32x8 __attribute__((ext_vector_type(8)));
typedef GAS unsigned gu32;
#define RLX_AGENT __ATOMIC_RELAXED, __HIP_MEMORY_SCOPE_AGENT

constexpr int DM = 2048, NB = 4, SEQ = 2048, NTOK = NB * SEQ;
constexpr int NPROJ = 14336;
constexpr int INW = 14352;
constexpr int NEXP = 32, TOPK = 4, NSLOT = NTOK * TOPK;
constexpr int MAXTILE = 160;
constexpr float EPS = 1e-6f;

constexpr size_t MiB = 1u << 20;
constexpr size_t WS_CTL = 0, CTL_ZERO_BYTES = 128 * 1024;
constexpr size_t WS_MOD = 2 * MiB;
constexpr size_t WS_RWP = 3 * MiB;
constexpr size_t WS_BIASP = 4 * MiB;
constexpr size_t WS_WG_T = 4 * MiB + 4096;
constexpr size_t WS_LNP = 5 * MiB;
constexpr size_t WS_DC = 7 * MiB;
constexpr size_t WS_TOPW = 8 * MiB;
constexpr size_t WS_LIST = 9 * MiB;
constexpr size_t WS_WIN_T = 16 * MiB;
constexpr size_t WS_WA_T = 72 * MiB, WS_WB_T = 80 * MiB, WS_WOUT_T = 88 * MiB;
constexpr size_t WS_WGU_T = 96 * MiB;
constexpr size_t WS_WDN_T = 608 * MiB;
constexpr size_t WS_H = 864 * MiB;
constexpr size_t WS_AU = 896 * MiB, WS_AV = 928 * MiB, WS_Q = 960 * MiB, WS_K = 976 * MiB, WS_V = 992 * MiB, WS_R = 1024 * MiB, WS_GA = 1056 * MiB, WS_GB = 1088 * MiB;
constexpr size_t WS_QD = 1120 * MiB, WS_KST = 1136 * MiB, WS_ATT = 1152 * MiB;
constexpr size_t WS_O = 1160 * MiB, WS_YA = 1192 * MiB, WS_YB = 1224 * MiB, WS_MERGED = 1256 * MiB, WS_X1 = 1288 * MiB, WS_M1 = 1352 * MiB;
constexpr size_t WS_H8 = WS_M1;
constexpr size_t WS_WIN8 = WS_M1 + 16 * MiB;
constexpr size_t WS_HS = 10 * MiB;
constexpr size_t WS_WS = 10 * MiB + 65536;
constexpr int CW_CMAX = 16384;
constexpr size_t WS_ACT = 1416 * MiB;
constexpr size_t WS_Y = 1576 * MiB;
constexpr size_t WS_END = 1704 * MiB;
constexpr int CW_TMO = 0, CW_CODE = 1, CW_CNT = 64, CW_BAR = 4096;

constexpr int RING_BYTES = 131072;
constexpr int LDSCTL_OFF = RING_BYTES, MISC_OFF = LDSCTL_OFF + 320;
constexpr int TAB_OFF = RING_BYTES + 1024;
constexpr int LDS_BYTES = 147456;

typedef __bf16 bf16x2_t __attribute__((ext_vector_type(2)));
__device__ __forceinline__ unsigned cvt_pk_bf16(float lo, float hi) { const f32x2 v = {lo, hi}; const bf16x2_t b = __builtin_convertvector(v, bf16x2_t); unsigned r; __builtin_memcpy(&r, &b, 4); return r; }
__device__ __forceinline__ float bf2f(unsigned short b) { return __uint_as_float(((unsigned)b) << 16); }
__device__ __forceinline__ float bflo(unsigned w) { return __uint_as_float(w << 16); }
__device__ __forceinline__ float bfhi(unsigned w) { return __uint_as_float(w & 0xffff0000u); }
__device__ __forceinline__ float fast_sigmoid(float x) { return __builtin_amdgcn_rcpf(1.0f + __expf(-x)); }
__device__ __forceinline__ float gelu_tanh(float x) { const float u = 0.7978845608f * (x + 0.044715f * x * x * x); return x * fast_sigmoid(2.0f * u); }
__device__ __forceinline__ float wave_sum(float v) {
#pragma unroll
    for (int o = 1; o < 64; o <<= 1) v += __shfl_xor(v, o);
    return v;
}

typedef short s16x4 __attribute__((ext_vector_type(4)));
__device__ __forceinline__ bf16x8 tr_frag(const LAS bf16_t* tile, int pitch, int row0, int col0, int fr, int fq) {
    const LAS bf16_t* a = tile + (row0 + 8 * fq + (fr >> 2)) * pitch + col0 + 4 * (fr & 3);
    const s16x4 lo = __builtin_amdgcn_ds_read_tr16_b64_v4i16((LAS s16x4*)a), hi = __builtin_amdgcn_ds_read_tr16_b64_v4i16((LAS s16x4*)(a + 4 * pitch));
    return (bf16x8){lo[0], lo[1], lo[2], lo[3], hi[0], hi[1], hi[2], hi[3]};
}

__device__ __forceinline__ unsigned cvt4_fp8(float a, float b, float c, float d) { int w = __builtin_amdgcn_cvt_pk_fp8_f32(a, b, 0, false); w = __builtin_amdgcn_cvt_pk_fp8_f32(c, d, w, true); return (unsigned)w; }
constexpr float W8_SCALE = 64.0f, W8_INV = 1.0f / 64.0f;
#define LDS_WAIT() asm volatile("s_waitcnt lgkmcnt(0)" ::: "memory")
#define VM_WAIT() asm volatile("s_waitcnt vmcnt(0)" ::: "memory")

#define XB_TMO      128
#define XB_XCNT(j)  (256  + 64 * (j))
#define XB_XSUB(j)  (1280 + 64 * (j))
#define XB_XGEN(j)  (2304 + 64 * (j))
#define XB_TOP      3328
#define XB_TOPGEN   3392
#define XCD_BAR_WORDS 3456
#define XB_SPIN_CAP (1u << 18)
__device__ __forceinline__ unsigned xb_ld(unsigned* p)              { return __hip_atomic_load(p, __ATOMIC_RELAXED, __HIP_MEMORY_SCOPE_AGENT); }
__device__ __forceinline__ unsigned xb_add(unsigned* p, unsigned v) { return __hip_atomic_fetch_add(p, v, __ATOMIC_RELAXED, __HIP_MEMORY_SCOPE_AGENT); }
__device__ __forceinline__ unsigned xb_xcc_id() { return (unsigned)__builtin_amdgcn_s_getreg((3 << 11) | 20) & 0xFu; }
#define XB_SPIN(cond, bar) do { unsigned _sp = 0; while (cond) { __builtin_amdgcn_s_sleep(1); \
    if ((++_sp & 255u) == 0u) { if (xb_ld(&(bar)[XB_TMO])) break; if (_sp > XB_SPIN_CAP) { atomicAdd(&(bar)[XB_TMO], 1u); break; } } } } while (0)
struct XcdBarrier { unsigned* bar; unsigned x; volatile LAS unsigned* st; };
__device__ __forceinline__ XcdBarrier xcd_barrier_post(unsigned* bar, volatile LAS unsigned* st) {
    XcdBarrier b; b.bar = bar; b.x = xb_xcc_id(); b.st = st;
    if (threadIdx.x == 0) (void)xb_add(&bar[XB_XCNT(b.x)], 1u);
    return b;
}
__device__ __forceinline__ void xcd_barrier_complete(unsigned* bar, unsigned x, unsigned& nloc, unsigned& nx) {
    const unsigned G = gridDim.x * gridDim.y * gridDim.z;
    unsigned sum, cnt, mine, sp = 0u;
    for (;;) {
        sum = 0u; cnt = 0u; mine = 0u;
#pragma unroll
        for (unsigned j = 0; j < 16; ++j) { const unsigned c = xb_ld(&bar[XB_XCNT(j)]); sum += c; cnt += (c > 0u) ? 1u : 0u; mine = (j == x) ? c : mine; }
        if (sum == G) break;
        __builtin_amdgcn_s_sleep(1);
        if ((++sp & 255u) == 0u) { if (xb_ld(&bar[XB_TMO])) break; if (sp > XB_SPIN_CAP) { atomicAdd(&bar[XB_TMO], 1u); break; } }
    }
    nloc = mine > 0u ? mine : 1u; nx = cnt > 0u ? cnt : 1u;
}
__device__ __forceinline__ void xcd_barrier(const XcdBarrier& b) {
    asm volatile("s_waitcnt vmcnt(0)" ::: "memory");
    __syncthreads();
    if (threadIdx.x == 0) {
        unsigned* bar = b.bar;
        __builtin_amdgcn_s_waitcnt(0);
        unsigned nloc = b.st[0], nx = b.st[1];
        if (nloc == 0u) { xcd_barrier_complete(bar, b.x, nloc, nx); b.st[0] = nloc; b.st[1] = nx; }
        const unsigned old = xb_add(&bar[XB_XSUB(b.x)], 1u);
        const unsigned gen = old / nloc;
        if (old + 1u == (gen + 1u) * nloc) {
            __builtin_amdgcn_fence(__ATOMIC_RELEASE, "agent");
            asm volatile("s_waitcnt vmcnt(0)" ::: "memory");
            const unsigned og = xb_add(&bar[XB_TOP], 1u);
            const unsigned tg = og / nx;
            if (og + 1u == (tg + 1u) * nx) xb_add(&bar[XB_TOPGEN], 1u);
            else XB_SPIN(xb_ld(&bar[XB_TOPGEN]) == tg, bar);
            __builtin_amdgcn_fence(__ATOMIC_ACQUIRE, "agent");
            xb_add(&bar[XB_XGEN(b.x)], 1u);
            asm volatile("s_waitcnt vmcnt(0)" ::: "memory");
        } else {
            XB_SPIN(xb_ld(&bar[XB_XGEN(b.x)]) == gen, bar);
            __builtin_amdgcn_fence(__ATOMIC_ACQUIRE, "agent");
            asm volatile("s_waitcnt vmcnt(0)" ::: "memory");
        }
    }
    __syncthreads();
}

typedef f32x4 Acc[2][2][4][2];
namespace pg8 {
constexpr int BM = 256, BK = 64, HALF = 128, HTB = HALF * BK * 2, NXCD = 8, WGM = 8;
__host__ __device__ __forceinline__ int lds_byte(int r, int c) { const int st = (r >> 4) * 2 + (c >> 5), rr = r & 15, cc = c & 31, ob = rr * 64 + cc * 2; return st * 1024 + (ob ^ (((ob >> 9) & 1) << 5)); }
__host__ __device__ __forceinline__ void stage_rc(int b, int& R, int& C) { const int st = b / 1024, sb = b % 1024, swz = sb ^ (((sb >> 9) & 1) << 5); R = (st >> 1) * 16 + swz / 64; C = (st & 1) * 32 + (swz % 64) / 2; }
__host__ __device__ __forceinline__ int perm32(int rho) { const int n = rho >> 4, i = rho & 15; return 8 * (i >> 2) + 4 * n + (i & 3); }

struct Unit { int pm, pn, e; };
struct Order {
    int nM, nN, nwg, G, c;
    __device__ __forceinline__ void init(int nM_, int nN_, int G_, int c_) { nM = nM_; nN = nN_; nwg = nM * nN; G = G_; c = c_; }
    __device__ __forceinline__ bool idx(int i, int& pm, int& pn) const {
        const long L = (long)i * G + c; if (L >= nwg) return false;
        int wgid = (int)L; { const int q = nwg / NXCD, r = nwg % NXCD, xcd = wgid % NXCD, off = wgid / NXCD; wgid = (xcd < r ? xcd * (q + 1) : r * (q + 1) + (xcd - r) * q) + off; }
        const int nig = WGM * nN, gid = wgid / nig, fm = gid * WGM, gsz = (nM - fm) < WGM ? (nM - fm) : WGM;
        pm = fm + ((wgid % nig) % gsz); pn = (wgid % nig) / gsz; return true;
    }
};

template <class Epi, class Sched>
__device__ __forceinline__ void gemm_phase(LAS unsigned char* lds, const Sched& S, const Epi& E, const int K) {
    const int tid = threadIdx.x, wid = __builtin_amdgcn_readfirstlane(tid >> 6), lane = tid & 63, wr = wid >> 2, wc = wid & 3, fr = lane & 15, fq = lane >> 4;
    constexpr bool I8 = Sched::I8;
    constexpr bool FP8 = Sched::FP8;
    const int nt = (FP8 || I8) ? K / 128 : K / BK; const int pitch = (FP8 || I8) ? K : 2 * K;
    int Rr[2], Cc[2]; unsigned voffA[2], voffB[2];
#pragma unroll
    for (int i = 0; i < 2; ++i) { stage_rc(tid * 16 + i * 8192, Rr[i], Cc[i]); const int Rb = Epi::PERM ? ((Rr[i] & ~31) + perm32(Rr[i] & 31)) : Rr[i];
        voffA[i] = (unsigned)(Rr[i] * pitch + Cc[i] * 2); voffB[i] = (unsigned)(Rb * pitch + Cc[i] * 2); }
    const size_t kstep = (size_t)(BK * 2);
    const size_t hstep = (size_t)HALF * pitch;
    const unsigned ldsw = (unsigned)wid * 1024u;
    const int aoff = lds_byte(wr * 64 + fr, fq * 8), boff = lds_byte(wc * 32 + fr, fq * 8);
#define PG8_SA(b, h) (((b) * 2 + (h)) * HTB)
#define PG8_SB(b, h) ((4 + (b) * 2 + (h)) * HTB)
#define PG8_GLDS(gptr, bufoff, i) __builtin_amdgcn_global_load_lds((const unsigned*)(gptr), (LAS unsigned*)(lds + (bufoff) + ldsw + (i) * 8192), 16, 0, 0)
#define PG8_STAGE_B(bufoff, gbase) do { _Pragma("unroll") for (int _i = 0; _i < 2; ++_i) PG8_GLDS((const char*)(gbase) + voffB[_i], bufoff, _i); } while (0)
#define PG8_STAGE_A(bufoff, TP, AO, h, koff) do { _Pragma("unroll") for (int _i = 0; _i < 2; ++_i) { \
        if constexpr (Sched::GATHER) PG8_GLDS(S.a_base() + (size_t)(koff) + AO[h][_i], bufoff, _i); \
        else PG8_GLDS((TP) + (size_t)(koff) + ((h) ? hstep : (size_t)0) + voffA[_i], bufoff, _i); } } while (0)
#define PG8_LDA(dst, b, h) do { _Pragma("unroll") for (int m = 0; m < 4; ++m) _Pragma("unroll") for (int k = 0; k < 2; ++k) dst[m][k] = *(const LAS bf16x8*)(lds + PG8_SA(b, h) + aoff + m * 2048 + k * 1024); } while (0)
#define PG8_LDB(dst, b, h) do { _Pragma("unroll") for (int n = 0; n < 2; ++n) _Pragma("unroll") for (int k = 0; k < 2; ++k) dst[n][k] = *(const LAS bf16x8*)(lds + PG8_SB(b, h) + boff + n * 2048 + k * 1024); } while (0)
#define PG8_CAT(x) __builtin_shufflevector(__builtin_bit_cast(i32x4, (x)[0]), __builtin_bit_cast(i32x4, (x)[1]), 0, 1, 2, 3, 4, 5, 6, 7)
#define PG8_MMA(ai, bj, At, Bt) do { __builtin_amdgcn_s_setprio(1); _Pragma("unroll") for (int m = 0; m < 4; ++m) _Pragma("unroll") for (int n = 0; n < 2; ++n) { \
        if constexpr (FP8) { const i32x8 _b = PG8_CAT(Bt[n]), _a = PG8_CAT(At[m]);   \
            asm volatile("v_mfma_scale_f32_16x16x128_f8f6f4 %0, %1, %2, %0, %3, %3 op_sel_hi:[0,0,0]" : "+v"(acc[ai][bj][m][n]) : "v"(_b), "v"(_a), "v"(0x7F7F7F7F)); } \
        else if constexpr (I8) { _Pragma("unroll") for (int k = 0; k < 2; ++k) acc[ai][bj][m][n] = __builtin_bit_cast(f32x4, __builtin_amdgcn_mfma_i32_16x16x64_i8(__builtin_bit_cast(i32x4, Bt[n][k]), __builtin_bit_cast(i32x4, At[m][k]), __builtin_bit_cast(i32x4, acc[ai][bj][m][n]), 0, 0, 0)); } \
        else { _Pragma("unroll") for (int k = 0; k < 2; ++k) acc[ai][bj][m][n] = __builtin_amdgcn_mfma_f32_16x16x32_bf16(Bt[n][k], At[m][k], acc[ai][bj][m][n], 0, 0, 0); } } __builtin_amdgcn_s_setprio(0); } while (0)
#define PG8_WAIT_V(n) asm volatile("s_waitcnt vmcnt(" #n ")" ::: "memory")
#define PG8_WAIT_L(n) asm volatile("s_waitcnt lgkmcnt(" #n ")" ::: "memory")
#define PG8_BAR __builtin_amdgcn_s_barrier()
#define PG8_SCHED __builtin_amdgcn_sched_barrier(0)
    Unit cur, nxt; int ui = 0;
    if (!S.next(0, cur)) return;
    f32x4 acc[2][2][4][2];
#pragma unroll
    for (int a = 0; a < 2; ++a)
#pragma unroll
        for (int b = 0; b < 2; ++b)
#pragma unroll
            for (int m = 0; m < 4; ++m)
#pragma unroll
                for (int n = 0; n < 2; ++n) acc[a][b][m][n] = (f32x4){0.f, 0.f, 0.f, 0.f};
    bf16x8 At[4][2], B0[2][2], B1[2][2];
    unsigned aoC[2][2] = {{0u, 0u}, {0u, 0u}}, aoN[2][2] = {{0u, 0u}, {0u, 0u}};
    if constexpr (Sched::GATHER) S.a_offs(0, cur, Rr, Cc, aoC);
    const char* cA = S.a_tile(cur); const char* cB = S.b_tile(cur);
    PG8_STAGE_B(PG8_SB(0, 0), cB); PG8_STAGE_B(PG8_SB(0, 1), cB + hstep); PG8_STAGE_A(PG8_SA(0, 0), cA, aoC, 0, 0); PG8_STAGE_A(PG8_SA(0, 1), cA, aoC, 1, 0);
    if (wr == 1) PG8_BAR;
    PG8_WAIT_V(2); PG8_BAR;
    PG8_STAGE_B(PG8_SB(1, 0), cB + kstep); PG8_STAGE_A(PG8_SA(1, 0), cA, aoC, 0, kstep); PG8_STAGE_B(PG8_SB(1, 1), cB + hstep + kstep);
    PG8_WAIT_V(6); PG8_BAR;
    for (;;) {
        const bool has_next = S.next(ui + 1, nxt);
        const char* nA = has_next ? S.a_tile(nxt) : cA; const char* nB = has_next ? S.b_tile(nxt) : cB;
        if constexpr (Sched::GATHER) { if (has_next) S.a_offs(ui + 1, nxt, Rr, Cc, aoN); else {
#pragma unroll
            for (int h = 0; h < 2; ++h)
#pragma unroll
                for (int i = 0; i < 2; ++i) aoN[h][i] = aoC[h][i]; } }
        constexpr int NSEG = Epi::MIDK ? 2 : 1;
#pragma unroll 1
        for (int seg = 0; seg < NSEG; ++seg) {
        if constexpr (Epi::MIDK) { if (seg == 1) { Acc& accr = acc; E.midk(accr, cur, wr, wc, fr, fq); } }
#pragma unroll 1
        for (int t = seg * (nt / NSEG); t < (seg + 1) * (nt / NSEG); t += 2) {
            const bool last = (t == nt - 2);
            const size_t k1 = (size_t)(t + 1) * kstep;
            const size_t k2 = last ? (size_t)0 : (size_t)(t + 2) * kstep, k3 = k2 + kstep;
            const char* a2 = last ? nA : cA; const char* b2 = last ? nB : cB + (size_t)(t + 2) * kstep; const char* b3 = b2 + kstep;
            unsigned ax[2][2];
#pragma unroll
            for (int h = 0; h < 2; ++h)
#pragma unroll
                for (int i = 0; i < 2; ++i) ax[h][i] = last ? aoN[h][i] : aoC[h][i];
            PG8_LDB(B0, 0, 0); PG8_LDB(B1, 0, 1); PG8_SCHED; PG8_LDA(At, 0, 0); PG8_STAGE_A(PG8_SA(1, 1), cA, aoC, 1, k1);
            PG8_WAIT_V(8); PG8_WAIT_L(0); PG8_BAR; PG8_MMA(0, 0, At, B0); PG8_MMA(0, 1, At, B1); PG8_BAR; PG8_SCHED;
            PG8_LDA(At, 0, 1); PG8_STAGE_B(PG8_SB(0, 0), b2); PG8_STAGE_B(PG8_SB(0, 1), b2 + hstep); PG8_STAGE_A(PG8_SA(0, 0), a2, ax, 0, k2);
            PG8_WAIT_V(8); PG8_WAIT_L(0); PG8_BAR; PG8_MMA(1, 0, At, B0); PG8_MMA(1, 1, At, B1); PG8_BAR; PG8_SCHED;
            PG8_LDB(B0, 1, 0); PG8_LDB(B1, 1, 1); PG8_SCHED; PG8_LDA(At, 1, 0); PG8_STAGE_A(PG8_SA(0, 1), a2, ax, 1, k2);
            PG8_WAIT_V(8); PG8_WAIT_L(0); PG8_BAR; PG8_MMA(0, 0, At, B0); PG8_MMA(0, 1, At, B1); PG8_BAR; PG8_SCHED;
            PG8_LDA(At, 1, 1); PG8_STAGE_B(PG8_SB(1, 0), b3); PG8_STAGE_B(PG8_SB(1, 1), b3 + hstep); PG8_STAGE_A(PG8_SA(1, 0), a2, ax, 0, k3);
            PG8_WAIT_V(8); PG8_WAIT_L(0); PG8_BAR; PG8_MMA(1, 0, At, B0); PG8_MMA(1, 1, At, B1); PG8_BAR; PG8_SCHED;
        }
        }
        if (wr == 0) PG8_BAR;
        E(acc, cur, ui, wr, wc, fr, fq);
        if (!has_next) break;
#pragma unroll
        for (int a = 0; a < 2; ++a)
#pragma unroll
            for (int b = 0; b < 2; ++b)
#pragma unroll
                for (int m = 0; m < 4; ++m)
#pragma unroll
                    for (int n = 0; n < 2; ++n) acc[a][b][m][n] = (f32x4){0.f, 0.f, 0.f, 0.f};
        cur = nxt; cA = nA; cB = nB; ++ui;
#pragma unroll
        for (int h = 0; h < 2; ++h)
#pragma unroll
            for (int i = 0; i < 2; ++i) aoC[h][i] = aoN[h][i];
        if (wr == 1) PG8_BAR;
    }
    PG8_WAIT_V(0);
    PG8_BAR;
#undef PG8_SA
#undef PG8_SB
#undef PG8_GLDS
#undef PG8_STAGE_A
#undef PG8_STAGE_B
#undef PG8_LDA
#undef PG8_LDB
#undef PG8_MMA
#undef PG8_CAT
#undef PG8_WAIT_V
#undef PG8_WAIT_L
#undef PG8_BAR
#undef PG8_SCHED
}
}
using pg8::Unit;

struct Params { const float* in[26]; float* out; unsigned char* ws; int ph_lo, ph_hi, li, pad; };
enum { I_X = 0, I_C, I_ADAW, I_ADAB, I_N1G, I_WIN, I_GW2, I_GGB, I_LNG, I_LNB, I_SGW, I_SGB, I_GNG, I_WA, I_WB, I_WOUT, I_N2G, I_RW, I_RB, I_EWG, I_EBG, I_EWU, I_EBU, I_EWD, I_EBD, I_FG };
#define WSP(T, off) ((T*)(p.ws + (off)))

struct DenseSched8 {
    static constexpr bool GATHER = false, FP8 = false, I8 = true;
    pg8::Order o; const char* A; const char* Bt; int K, pn0;
    __device__ __forceinline__ bool next(int i, Unit& u) const { u.e = 0; if (!o.idx(i, u.pm, u.pn)) return false; u.pn += pn0; return true; }
    __device__ __forceinline__ const char* a_base() const { return A; }
    __device__ __forceinline__ const char* a_tile(const Unit& u) const { return A + (size_t)u.pm * 256 * K; }
    __device__ __forceinline__ const char* b_tile(const Unit& u) const { return Bt + (size_t)(u.pn - pn0) * 256 * K; }
    __device__ __forceinline__ void a_offs(int, const Unit&, const int (&)[2], const int (&)[2], unsigned (&)[2][2]) const {}
};
template <bool F8> struct DenseSchedT {
    static constexpr bool GATHER = false, FP8 = F8, I8 = false; static constexpr int ES = F8 ? 1 : 2;
    pg8::Order o; const char* A; const char* Bt; int K;
    __device__ __forceinline__ bool next(int i, Unit& u) const { u.e = 0; return o.idx(i, u.pm, u.pn); }
    __device__ __forceinline__ const char* a_base() const { return A; }
    __device__ __forceinline__ const char* a_tile(const Unit& u) const { return A + (size_t)u.pm * 256 * K * ES; }
    __device__ __forceinline__ const char* b_tile(const Unit& u) const { return Bt + (size_t)u.pn * 256 * K * ES; }
    __device__ __forceinline__ void a_offs(int, const Unit&, const int (&)[2], const int (&)[2], unsigned (&)[2][2]) const {}
};
typedef DenseSchedT<false> DenseSched; typedef DenseSchedT<(MIX8 & 1) != 0> SchedM; typedef DenseSchedT<(MIX8 & 4) != 0> SchedO;
constexpr float MIXSM = (MIX8 & 1) ? W8_INV : 1.0f;
constexpr float MIXSO = (MIX8 & 4) ? W8_INV : 1.0f;
struct Moe1Sched {
    static constexpr bool GATHER = true, FP8 = true, I8 = false;
    pg8::Order o; const char* A; const char* W; const LAS int* tab; const LAS unsigned* goff;
    __device__ __forceinline__ bool next(int i, Unit& u) const { if (!o.idx(i, u.pm, u.pn)) return false; u.e = __builtin_amdgcn_readfirstlane(tab[72 + u.pm]); return true; }
    __device__ __forceinline__ const char* a_base() const { return A; }
    __device__ __forceinline__ const char* a_tile(const Unit&) const { return A; }
    __device__ __forceinline__ const char* b_tile(const Unit& u) const { return W + ((size_t)u.e * 4096 + (size_t)u.pn * 256) * 2048; }
    __device__ __forceinline__ void a_offs(int i, const Unit&, const int (&R)[2], const int (&C)[2], unsigned (&ao)[2][2]) const {
#pragma unroll
        for (int h = 0; h < 2; ++h)
#pragma unroll
            for (int j = 0; j < 2; ++j) ao[h][j] = goff[i * 256 + h * 128 + R[j]] + (unsigned)C[j] * 2u;
    }
};
struct Moe2Sched {
    static constexpr bool GATHER = false, FP8 = true, I8 = false;
    pg8::Order o; const char* A; const char* W; const LAS int* tab;
    __device__ __forceinline__ bool next(int i, Unit& u) const { if (!o.idx(i, u.pm, u.pn)) return false; u.e = __builtin_amdgcn_readfirstlane(tab[72 + u.pm]); return true; }
    __device__ __forceinline__ const char* a_base() const { return A; }
    __device__ __forceinline__ const char* a_tile(const Unit& u) const { return A + (size_t)u.pm * 256 * 2048; }
    __device__ __forceinline__ const char* b_tile(const Unit& u) const { return W + ((size_t)u.e * 2048 + (size_t)u.pn * 256) * 2048; }
    __device__ __forceinline__ void a_offs(int, const Unit&, const int (&)[2], const int (&)[2], unsigned (&)[2][2]) const {}
};

__device__ __forceinline__ u32x4 pack8(const f32x4 v0, const f32x4 v1) { u32x4 w; w.x = cvt_pk_bf16(v0[0], v0[1]); w.y = cvt_pk_bf16(v0[2], v0[3]); w.z = cvt_pk_bf16(v1[0], v1[1]); w.w = cvt_pk_bf16(v1[2], v1[3]); return w; }
template <int ACT> __device__ __forceinline__ float act_f(float x) {
    if (ACT == 1) return gelu_tanh(x);
    if (ACT == 2) return x * fast_sigmoid(x);
    if (ACT == 3) return fast_sigmoid(x);
    return x;
}
struct EpiProj {
    static constexpr bool PERM = true, MIDK = false;
    unsigned char* ws; bool i8;
    __device__ __forceinline__ void operator()(const Acc& acc, const Unit& u, int, int wr, int wc, int fr, int fq) const {
        const int pn = u.pn, row0 = u.pm * 256 + wr * 64 + fr, cw = wc * 32 + 8 * fq;
        int act, ldc = 2048, pl; size_t boff;
        if (pn < 8)       { act = 1; boff = WS_AU; pl = pn; }
        else if (pn < 16) { act = 1; boff = WS_AV; pl = pn - 8; }
        else if (pn < 20) { act = 0; boff = WS_Q; pl = pn - 16; ldc = 1024; }
        else if (pn < 24) { act = 0; boff = WS_K; pl = pn - 20; ldc = 1024; }
        else if (pn < 32) { act = 0; boff = WS_V; pl = pn - 24; }
        else if (pn < 40) { act = 2; boff = WS_R; pl = pn - 32; }
        else if (pn < 48) { act = 3; boff = WS_GA; pl = pn - 40; }
        else              { act = 3; boff = WS_GB; pl = pn - 48; }
        const bool lns = (pn >= 8 && pn < 16);
        bf16_t* base = (bf16_t*)(ws + boff); const int col0 = pl * 256 + cw;
        float* lnp = (float*)(ws + WS_LNP) + (pl * 4 + wc) * 2;
        f32x4 wsc[2][2];
#pragma unroll
        for (int bj = 0; bj < 2; ++bj) { const float* wp = (const float*)(ws + WS_WS) + pn * 256 + bj * 128 + cw; wsc[bj][0] = i8 ? *(const f32x4*)wp : (f32x4){1.f, 1.f, 1.f, 1.f}; wsc[bj][1] = i8 ? *(const f32x4*)(wp + 4) : (f32x4){1.f, 1.f, 1.f, 1.f}; }
        if (act == 0) {
#pragma unroll
            for (int ai = 0; ai < 2; ++ai)
#pragma unroll
                for (int m = 0; m < 4; ++m) { const int row = row0 + ai * 128 + m * 16; bf16_t* rowp = base + (size_t)row * ldc + col0; const float hs = i8 ? ((const float*)(ws + WS_HS))[row] : 1.0f;
#pragma unroll
                    for (int bj = 0; bj < 2; ++bj) { f32x4 v[2] = {acc[ai][bj][m][0], acc[ai][bj][m][1]};
                        if (i8) {
#pragma unroll
                            for (int j = 0; j < 4; ++j) { v[0][j] = (float)__float_as_int(v[0][j]) * (hs * wsc[bj][0][j]); v[1][j] = (float)__float_as_int(v[1][j]) * (hs * wsc[bj][1][j]); } }
                        *(u32x4*)(rowp + bj * 128) = pack8(v[0], v[1]); }
                    asm volatile("" ::: "memory"); }
            return;
        }
#pragma unroll
        for (int ai = 0; ai < 2; ++ai)
#pragma unroll
            for (int m = 0; m < 4; ++m) { const int row = row0 + ai * 128 + m * 16; bf16_t* rowp = base + (size_t)row * ldc + col0; float s = 0.f, q = 0.f;
                const float hs = i8 ? ((const float*)(ws + WS_HS))[row] : 1.0f;
#pragma unroll
                for (int bj = 0; bj < 2; ++bj) { f32x4 v[2] = {acc[ai][bj][m][0], acc[ai][bj][m][1]};
                    if (i8) {
#pragma unroll
                        for (int j = 0; j < 4; ++j) { v[0][j] = (float)__float_as_int(v[0][j]) * (hs * wsc[bj][0][j]); v[1][j] = (float)__float_as_int(v[1][j]) * (hs * wsc[bj][1][j]); } }
#pragma unroll
                    for (int h = 0; h < 2; ++h)
#pragma unroll
                        for (int j = 0; j < 4; ++j) { const float x = v[h][j]; const float t = (act == 1) ? 1.5957691216f * (x + 0.044715f * x * x * x) : x;
                            const float sg = fast_sigmoid(t); v[h][j] = (act == 3) ? sg : x * sg; }
                    if (lns) {
#pragma unroll
                        for (int h = 0; h < 2; ++h)
#pragma unroll
                            for (int j = 0; j < 4; ++j) { s += v[h][j]; q += v[h][j] * v[h][j]; } }
                    *(u32x4*)(rowp + bj * 128) = pack8(v[0], v[1]); }
                if (lns) { s += __shfl_xor(s, 16); s += __shfl_xor(s, 32); q += __shfl_xor(q, 16); q += __shfl_xor(q, 32);
                    if ((threadIdx.x & 63) < 16) *(f32x2*)(lnp + (size_t)row * 64) = (f32x2){s, q}; }
                asm volatile("" ::: "memory"); }
    }
};
struct EpiMerge {
    static constexpr bool PERM = true, MIDK = true;
    const bf16_t* GA; const bf16_t* GB; bf16_t* O;
    __device__ __forceinline__ void midk(Acc& acc, const Unit& u, int wr, int wc, int fr, int fq) const {
        const size_t off0 = (size_t)(u.pm * 256 + wr * 64 + fr) * 2048 + u.pn * 256 + wc * 32 + 8 * fq;
        const bf16_t* pa = GA + off0; const bf16_t* pb = GB + off0;
#pragma unroll
        for (int ai = 0; ai < 2; ++ai) {
#pragma unroll
            for (int m = 0; m < 4; ++m) {
#pragma unroll
                for (int bj = 0; bj < 2; ++bj) { const u32x4 a = *(const u32x4*)(pa + bj * 128), b = *(const u32x4*)(pb + bj * 128);
                    const unsigned aw[4] = {a.x, a.y, a.z, a.w}, bw[4] = {b.x, b.y, b.z, b.w};
#pragma unroll
                    for (int j = 0; j < 4; ++j) { const float r0 = bflo(aw[j]) * __builtin_amdgcn_rcpf(fmaxf(bflo(bw[j]), 1e-30f)), r1 = bfhi(aw[j]) * __builtin_amdgcn_rcpf(fmaxf(bfhi(bw[j]), 1e-30f));
                        acc[ai][bj][m][j >> 1][2 * (j & 1)] *= r0; acc[ai][bj][m][j >> 1][2 * (j & 1) + 1] *= r1; } }
                pa += 16 * 2048; pb += 16 * 2048; asm volatile("" : "+v"(pa), "+v"(pb) :: "memory"); }
            pa += 64 * 2048; pb += 64 * 2048; asm volatile("" : "+v"(pa), "+v"(pb)); }
    }
    __device__ __forceinline__ void operator()(const Acc& acc, const Unit& u, int, int wr, int wc, int fr, int fq) const {
        const int row0 = u.pm * 256 + wr * 64 + fr, col0 = u.pn * 256 + wc * 32 + 8 * fq;
#pragma unroll
        for (int ai = 0; ai < 2; ++ai)
#pragma unroll
            for (int m = 0; m < 4; ++m) { const size_t off = (size_t)(row0 + ai * 128 + m * 16) * 2048 + col0;
#pragma unroll
                for (int bj = 0; bj < 2; ++bj) { const u32x4 g = *(const u32x4*)(GB + off + bj * 128);
                    f32x4 o0 = acc[ai][bj][m][0] * MIXSM, o1 = acc[ai][bj][m][1] * MIXSM;
                    o0[0] *= bflo(g.x); o0[1] *= bfhi(g.x); o0[2] *= bflo(g.y); o0[3] *= bfhi(g.y); o1[0] *= bflo(g.z); o1[1] *= bfhi(g.z); o1[2] *= bflo(g.w); o1[3] *= bfhi(g.w);
                    if (MIX8 & 4) { u32x2 w8; w8.x = cvt4_fp8(o0[0], o0[1], o0[2], o0[3]); w8.y = cvt4_fp8(o1[0], o1[1], o1[2], o1[3]); *(u32x2*)((unsigned char*)O + off + bj * 128) = w8; }
                    else *(u32x4*)(O + off + bj * 128) = pack8(o0, o1); } }
    }
};
struct EpiOut {
    static constexpr bool PERM = true, MIDK = false;
    const float* X; const float* MOD; float* X1;
    __device__ __forceinline__ void operator()(const Acc& acc, const Unit& u, int, int wr, int wc, int fr, int fq) const {
        const int row0 = u.pm * 256 + wr * 64 + fr, col0 = u.pn * 256 + wc * 32 + 8 * fq;
        const float* gt = MOD + (size_t)((u.pm * 256) >> 11) * 12288 + 2 * 2048 + col0;
        f32x4 g[2][2];
#pragma unroll
        for (int bj = 0; bj < 2; ++bj) { g[bj][0] = *(const f32x4*)(gt + bj * 128); g[bj][1] = *(const f32x4*)(gt + bj * 128 + 4); }
#pragma unroll
        for (int ai = 0; ai < 2; ++ai)
#pragma unroll
            for (int m = 0; m < 4; ++m) { const size_t off = (size_t)(row0 + ai * 128 + m * 16) * 2048 + col0;
#pragma unroll
                for (int bj = 0; bj < 2; ++bj) { const f32x4 x0 = *(const f32x4*)(X + off + bj * 128), x1 = *(const f32x4*)(X + off + bj * 128 + 4);
                    *(f32x4*)(X1 + off + bj * 128) = x0 + g[bj][0] * (acc[ai][bj][m][0] * MIXSO); *(f32x4*)(X1 + off + bj * 128 + 4) = x1 + g[bj][1] * (acc[ai][bj][m][1] * MIXSO); } }
    }
};
struct EpiAct {
    static constexpr bool PERM = true, MIDK = false;
    const float* bg; const float* bu; bf16_t* ACT;
    __device__ __forceinline__ void operator()(const Acc& acc, const Unit& u, int, int wr, int wc, int fr, int fq) const {
        const int row0 = u.pm * 256 + wr * 64 + fr, col0 = u.pn * 128 + wc * 32 + 8 * fq;
        const f32x4 g0 = *(const f32x4*)(bg + (size_t)u.e * 2048 + col0), g1 = *(const f32x4*)(bg + (size_t)u.e * 2048 + col0 + 4);
        const f32x4 u0 = *(const f32x4*)(bu + (size_t)u.e * 2048 + col0), u1 = *(const f32x4*)(bu + (size_t)u.e * 2048 + col0 + 4);
#pragma unroll
        for (int ai = 0; ai < 2; ++ai)
#pragma unroll
            for (int m = 0; m < 4; ++m) { f32x4 o0, o1;
#pragma unroll
                for (int j = 0; j < 4; ++j) {
                    float g = fminf(acc[ai][0][m][0][j] * W8_INV + g0[j], 7.0f), up = fminf(fmaxf(acc[ai][1][m][0][j] * W8_INV + u0[j], -7.0f), 7.0f); o0[j] = (up + 1.0f) * (g * fast_sigmoid(1.702f * g));
                    g = fminf(acc[ai][0][m][1][j] * W8_INV + g1[j], 7.0f); up = fminf(fmaxf(acc[ai][1][m][1][j] * W8_INV + u1[j], -7.0f), 7.0f); o1[j] = (up + 1.0f) * (g * fast_sigmoid(1.702f * g)); }
                u32x2 w; w.x = cvt4_fp8(o0[0], o0[1], o0[2], o0[3]); w.y = cvt4_fp8(o1[0], o1[1], o1[2], o1[3]);
                *(u32x2*)((unsigned char*)ACT + (size_t)(row0 + ai * 128 + m * 16) * 2048 + col0) = w; }
    }
};
struct EpiDown {
    static constexpr bool PERM = true, MIDK = false;
    const float* bd; bf16_t* Y; const int* LIST; const LAS int* tab;
    __device__ __forceinline__ void operator()(const Acc& acc, const Unit& u, int, int wr, int wc, int fr, int fq) const {
        const int e = u.e, rt = u.pm - tab[32 + e], cnt = tab[e];
        const int col0 = u.pn * 256 + wc * 32 + 8 * fq;
        f32x4 b[2][2];
#pragma unroll
        for (int bj = 0; bj < 2; ++bj) { b[bj][0] = *(const f32x4*)(bd + (size_t)e * 2048 + col0 + bj * 128); b[bj][1] = *(const f32x4*)(bd + (size_t)e * 2048 + col0 + bj * 128 + 4); }
#pragma unroll
        for (int ai = 0; ai < 2; ++ai)
#pragma unroll
            for (int m = 0; m < 4; ++m) { const int pos = rt * 256 + ai * 128 + wr * 64 + m * 16 + fr;
                if (pos < cnt) { const int slot = LIST[e * 8192 + pos]; bf16_t* rowp = Y + (size_t)slot * 2048 + col0;
#pragma unroll
                    for (int bj = 0; bj < 2; ++bj) *(u32x4*)(rowp + bj * 128) = pack8(acc[ai][bj][m][0] * W8_INV + b[bj][0], acc[ai][bj][m][1] * W8_INV + b[bj][1]); } }
    }
};

constexpr int NWAVES = 8;
template <bool F8> __device__ __forceinline__ void p0_transpose_item(const float* W, int ld, void* WT, int k0, int n0src, int rowdst, int lane, int dpitch = 2048, int dk0 = 0, LAS unsigned char* scr = nullptr) {
    const int n = lane & 31, h = lane >> 5; const float* src = W + (size_t)(k0 + 64 * h) * ld + n0src + n;
    float v[64];
#pragma unroll
    for (int i = 0; i < 64; ++i) v[i] = __builtin_nontemporal_load(src + (size_t)i * ld);
    if constexpr (F8) {
        if (scr) {
#pragma unroll
            for (int j = 0; j < 4; ++j) { u32x4 o;
#pragma unroll
                for (int q = 0; q < 4; ++q) o[q] = cvt4_fp8(v[16 * j + 4 * q] * W8_SCALE, v[16 * j + 4 * q + 1] * W8_SCALE, v[16 * j + 4 * q + 2] * W8_SCALE, v[16 * j + 4 * q + 3] * W8_SCALE);
                *(LAS u32x4*)(scr + (n * 9 + 4 * h + j) * 16) = o; }
            LDS_WAIT(); asm volatile("" ::: "memory");
#pragma unroll
            for (int j = 0; j < 4; ++j) { const int row = (lane >> 3) + 8 * j, pc = lane & 7; const u32x4 o = *(const LAS u32x4*)(scr + (row * 9 + pc) * 16);
                __builtin_nontemporal_store(o, (u32x4*)((unsigned char*)WT + (size_t)(rowdst + row) * dpitch + dk0 + k0 + 16 * pc)); }
            LDS_WAIT(); asm volatile("" ::: "memory");
        } else { unsigned char* dst = (unsigned char*)WT + (size_t)(rowdst + n) * dpitch + dk0 + k0 + 64 * h;
#pragma unroll
        for (int j = 0; j < 4; ++j) { u32x4 o;
#pragma unroll
            for (int q = 0; q < 4; ++q) o[q] = cvt4_fp8(v[16 * j + 4 * q] * W8_SCALE, v[16 * j + 4 * q + 1] * W8_SCALE, v[16 * j + 4 * q + 2] * W8_SCALE, v[16 * j + 4 * q + 3] * W8_SCALE);
            *(u32x4*)(dst + 16 * j) = o; } }
    } else { bf16_t* dst = (bf16_t*)WT + (size_t)(rowdst + n) * dpitch + dk0 + k0 + 64 * h;
#pragma unroll
        for (int j = 0; j < 8; ++j) { u32x4 o;
#pragma unroll
            for (int q = 0; q < 4; ++q) o[q] = cvt_pk_bf16(v[8 * j + 2 * q], v[8 * j + 2 * q + 1]);
            *(u32x4*)(dst + 8 * j) = o; } }
}
__device__ __forceinline__ void p0_prologue(const Params& p, LAS unsigned char* lds) {
    const int tid = threadIdx.x, lane = tid & 63, wave = __builtin_amdgcn_readfirstlane(tid >> 6), G = gridDim.x;
    if ((int)blockIdx.x < 192) {
        LAS float* sc = (LAS float*)lds; LAS float* red = (LAS float*)(lds + 32768);
        for (int i = tid; i < 4 * 2048; i += 512) { const float c = p.in[I_C][i]; sc[i] = c / (1.0f + expf(-c)); }
        __syncthreads();
        for (int item = blockIdx.x; item < 192; item += G) {
            const int cl = tid & 15, rg = tid >> 4; const float* w = p.in[I_ADAW] + item * 64 + 4 * cl;
            f32x4 a[4];
#pragma unroll
            for (int b = 0; b < 4; ++b) a[b] = (f32x4){0.f, 0.f, 0.f, 0.f};
#pragma unroll 8
            for (int i = 0; i < 64; ++i) { const int k = rg + 32 * i; const f32x4 wv = *(const f32x4*)(w + (size_t)k * 12288);
#pragma unroll
                for (int b = 0; b < 4; ++b) a[b] += wv * sc[b * 2048 + k]; }
#pragma unroll
            for (int b = 0; b < 4; ++b) *(LAS f32x4*)(red + (rg * 4 + b) * 64 + 4 * cl) = a[b];
            __syncthreads();
            if (tid < 256) { const int b = tid >> 6, col = tid & 63; float s = 0.f;
#pragma unroll 8
                for (int r = 0; r < 32; ++r) s += red[(r * 4 + b) * 64 + col];
                WSP(float, WS_MOD)[b * 12288 + item * 64 + col] = s + p.in[I_ADAB][item * 64 + col]; }
            __syncthreads();
        }
    }
    for (int i = blockIdx.x * 512 + tid; i < 16 * 2048; i += G * 512) { const int j = i >> 11, k = i & 2047; WSP(bf16_t, WS_WG_T)[i] = (bf16_t)(cvt_pk_bf16(p.in[I_WIN][(size_t)k * INW + 10240 + j], 0.f) & 0xffffu); }
    const int gw = blockIdx.x * NWAVES + wave, NGW = G * NWAVES;
    constexpr int IT_WIN = 16 * 448, IT_SQ = 16 * 64, IT_B = 3 * IT_SQ, IT_E = 32 * 3 * IT_SQ, NITEMS = IT_WIN + IT_B + IT_E;
    for (int it0 = gw; it0 < NITEMS; it0 += NGW) {
        int r = NITEMS - 1 - it0;
        if (r < IT_WIN) { const int kb = r / 448, nb = r % 448, n0 = 32 * nb; if (n0 < PROJ8_PN0 * 256) p0_transpose_item<false>(p.in[I_WIN], INW, WSP(bf16_t, WS_WIN_T), 128 * kb, n0 + (n0 >= 10240 ? 16 : 0), n0, lane);
            else p0_transpose_item<false>(p.in[I_WIN], INW, WSP(bf16_t, WS_WIN_T), 128 * kb, n0 + (n0 >= 10240 ? 16 : 0), n0, lane);
            continue; }
        r -= IT_WIN;
        if (r < IT_B) { const int which = r / IT_SQ, q = r % IT_SQ, kb = q >> 6, nb = q & 63;
            if (which < 2) { if (MIX8 & 1) p0_transpose_item<true>(p.in[I_WA + which], 2048, WSP(unsigned char, WS_WA_T), 128 * kb, 32 * nb, 32 * nb, lane, 4096, 2048 * which); else p0_transpose_item<false>(p.in[I_WA + which], 2048, WSP(bf16_t, WS_WA_T), 128 * kb, 32 * nb, 32 * nb, lane, 4096, 2048 * which); }
            else if (MIX8 & 4) p0_transpose_item<true>(p.in[I_WOUT], 2048, WSP(unsigned char, WS_WOUT_T), 128 * kb, 32 * nb, 32 * nb, lane);
            else p0_transpose_item<false>(p.in[I_WOUT], 2048, WSP(bf16_t, WS_WOUT_T), 128 * kb, 32 * nb, 32 * nb, lane);
            continue; }
        r -= IT_B;
        { const int e = r / (3 * IT_SQ), q3 = r % (3 * IT_SQ), which = q3 / IT_SQ, q = q3 % IT_SQ, kb = q >> 6, nb = q & 63, n0 = 32 * nb;
          LAS unsigned char* scr = lds + 65536 + wave * 8192;
          if (which < 2) p0_transpose_item<true>(p.in[which == 0 ? I_EWG : I_EWU] + (size_t)e * 2048 * 2048, 2048, WSP(unsigned char, WS_WGU_T) + (size_t)e * 4096 * 2048, 128 * kb, n0, (n0 >> 7) * 256 + (n0 & 127) + which * 128, lane, 2048, 0, scr);
          else p0_transpose_item<true>(p.in[I_EWD] + (size_t)e * 2048 * 2048, 2048, WSP(unsigned char, WS_WDN_T) + (size_t)e * 2048 * 2048, 128 * kb, n0, n0, lane, 2048, 0, scr); }
    }
}
__device__ __forceinline__ void p1_norm1(const Params& p) {
    const int tid = threadIdx.x, lane = tid & 63, wave = tid >> 6, G = gridDim.x, gw = blockIdx.x * NWAVES + wave, NGW = G * NWAVES;
    const float* MOD = WSP(float, WS_MOD);
    for (int m = gw; m < NTOK; m += NGW) {
        const int b = m >> 11; const float* xr = p.in[I_X] + (size_t)m * 2048; f32x4 v[8]; float s = 0.f;
#pragma unroll
        for (int j = 0; j < 8; ++j) { v[j] = *(const f32x4*)(xr + 4 * lane + 256 * j); s += (v[j][0] * v[j][0] + v[j][1] * v[j][1]) + (v[j][2] * v[j][2] + v[j][3] * v[j][3]); }
        const float rstd = rsqrtf(wave_sum(s) * (1.0f / 2048.0f) + EPS);
        bf16_t* hr = WSP(bf16_t, WS_H) + (size_t)m * 2048; float amax = 0.f;
#pragma unroll
        for (int j = 0; j < 8; ++j) { const int c = 4 * lane + 256 * j; const f32x4 g = *(const f32x4*)(p.in[I_N1G] + c), sc = *(const f32x4*)(MOD + b * 12288 + 2048 + c), sh = *(const f32x4*)(MOD + b * 12288 + c);
            const f32x4 o = v[j] * rstd * g * (sc + 1.0f) + sh; u32x2 w; w.x = cvt_pk_bf16(o[0], o[1]); w.y = cvt_pk_bf16(o[2], o[3]); *(u32x2*)(hr + c) = w;
            v[j] = o; amax = fmaxf(fmaxf(amax, fmaxf(fabsf(o[0]), fabsf(o[1]))), fmaxf(fabsf(o[2]), fabsf(o[3]))); }
        if (PROJ8_PN0 < 56) {
#pragma unroll
            for (int o = 1; o < 64; o <<= 1) amax = fmaxf(amax, __shfl_xor(amax, o));
            const float inv = amax > 0.f ? 127.0f / amax : 0.f; if (lane == 0) WSP(float, WS_HS)[m] = amax * (1.0f / 127.0f);
#pragma unroll
            for (int j = 0; j < 8; ++j) { const int c = 4 * lane + 256 * j; const int q0 = (int)rintf(v[j][0] * inv), q1 = (int)rintf(v[j][1] * inv), q2 = (int)rintf(v[j][2] * inv), q3 = (int)rintf(v[j][3] * inv);
                *(unsigned*)(WSP(unsigned char, WS_H8) + (size_t)m * 2048 + c) = (unsigned)(q0 & 255) | ((unsigned)(q1 & 255) << 8) | ((unsigned)(q2 & 255) << 16) | ((unsigned)q3 << 24); } }
    }
    for (int n = PROJ8_PN0 * 256 + gw; n < 14336; n += NGW) {
        const u32x4* src = (const u32x4*)(WSP(bf16_t, WS_WIN_T) + (size_t)n * 2048) + lane; float v[32]; float mx = 0.f;
#pragma unroll
        for (int j = 0; j < 4; ++j) { const u32x4 r = src[64 * j]; const unsigned rw_[4] = {r.x, r.y, r.z, r.w};
#pragma unroll
            for (int q = 0; q < 4; ++q) { v[8 * j + 2 * q] = bflo(rw_[q]); v[8 * j + 2 * q + 1] = bfhi(rw_[q]); mx = fmaxf(mx, fmaxf(fabsf(v[8 * j + 2 * q]), fabsf(v[8 * j + 2 * q + 1]))); } }
#pragma unroll
        for (int o = 1; o < 64; o <<= 1) mx = fmaxf(mx, __shfl_xor(mx, o));
        const float inv = mx > 0.f ? 127.0f / mx : 0.f; if (lane == 0) WSP(float, WS_WS)[n] = mx * (1.0f / 127.0f);
        unsigned char* dst = WSP(unsigned char, WS_WIN8) + (size_t)(n - PROJ8_PN0 * 256) * 2048;
#pragma unroll
        for (int j = 0; j < 4; ++j) { unsigned o[2];
#pragma unroll
            for (int q = 0; q < 2; ++q) { const int b0 = (int)rintf(v[8 * j + 4 * q] * inv), b1 = (int)rintf(v[8 * j + 4 * q + 1] * inv), b2 = (int)rintf(v[8 * j + 4 * q + 2] * inv), b3 = (int)rintf(v[8 * j + 4 * q + 3] * inv);
                o[q] = (unsigned)(b0 & 255) | ((unsigned)(b1 & 255) << 8) | ((unsigned)(b2 & 255) << 16) | ((unsigned)b3 << 24); }
            *(u32x2*)(dst + 8 * lane + 512 * j) = (u32x2){o[0], o[1]}; } }
    for (int i = blockIdx.x * 512 + tid; i < 4 * 2048 * 32; i += G * 512) { const int b = i >> 16, k = (i >> 5) & 2047, e = i & 31;
        WSP(float, WS_RWP)[i] = p.in[I_N2G][k] * (1.0f + MOD[b * 12288 + 4 * 2048 + k]) * p.in[I_RW][k * 32 + e]; }
    if (gw < 128) { const int b = gw >> 5, e = gw & 31; float s = 0.f;
        for (int k = lane; k < 2048; k += 64) s += MOD[b * 12288 + 3 * 2048 + k] * p.in[I_RW][k * 32 + e];
        s = wave_sum(s); if (lane == 0) WSP(float, WS_BIASP)[gw] = s + p.in[I_RB][e]; }
}
__device__ __forceinline__ void sg_unit(const Params& p, LAS unsigned char* lds, int unit) {
    const int tid = threadIdx.x, lane = tid & 63, w = __builtin_amdgcn_readfirstlane(tid >> 6), fr = lane & 15, fq = lane >> 4;
    const int nb = unit >> 3, g = unit & 7, row0 = nb * 128, c0 = g * 256;
    LAS float* stat = (LAS float*)lds; LAS bf16_t* vt = (LAS bf16_t*)(lds + 1024);
    if (tid < 128) { const float* lp = WSP(float, WS_LNP) + (size_t)(row0 + tid) * 64; float s = 0.f, q = 0.f;
#pragma unroll 8
        for (int i = 0; i < 32; ++i) { const f32x2 t = *(const f32x2*)(lp + 2 * i); s += t.x; q += t.y; }
        const float mu = s * (1.0f / 2048.0f), var = q * (1.0f / 2048.0f) - mu * mu; stat[2 * tid] = mu; stat[2 * tid + 1] = rsqrtf(fmaxf(var, 0.f) + EPS); }
    __syncthreads();
    const bf16_t* AV = WSP(bf16_t, WS_AV);
#pragma unroll 2
    for (int i = 0; i < 8; ++i) { const int idx = tid + 512 * i, s = idx >> 5, cc = idx & 31;
        const u32x4 raw = *(const u32x4*)(AV + (size_t)(row0 + s) * 2048 + c0 + 8 * cc);
        const f32x4 g0 = *(const f32x4*)(p.in[I_LNG] + c0 + 8 * cc), g1 = *(const f32x4*)(p.in[I_LNG] + c0 + 8 * cc + 4), b0 = *(const f32x4*)(p.in[I_LNB] + c0 + 8 * cc), b1 = *(const f32x4*)(p.in[I_LNB] + c0 + 8 * cc + 4);
        const float mu = stat[2 * s], rs = stat[2 * s + 1];
        u32x2 o0, o1;
        o0.x = cvt_pk_bf16((bflo(raw.x) - mu) * rs * g0[0] + b0[0], (bfhi(raw.x) - mu) * rs * g0[1] + b0[1]); o0.y = cvt_pk_bf16((bflo(raw.y) - mu) * rs * g0[2] + b0[2], (bfhi(raw.y) - mu) * rs * g0[3] + b0[3]);
        o1.x = cvt_pk_bf16((bflo(raw.z) - mu) * rs * g1[0] + b1[0], (bfhi(raw.z) - mu) * rs * g1[1] + b1[1]); o1.y = cvt_pk_bf16((bflo(raw.w) - mu) * rs * g1[2] + b1[2], (bfhi(raw.w) - mu) * rs * g1[3] + b1[3]);
        *(LAS u32x2*)(vt + s * 260 + 8 * cc) = o0; *(LAS u32x2*)(vt + s * 260 + 8 * cc + 4) = o1; }
    __syncthreads();
    f32x4 acc[8][2];
#pragma unroll
    for (int m = 0; m < 8; ++m) { acc[m][0] = (f32x4){0.f, 0.f, 0.f, 0.f}; acc[m][1] = (f32x4){0.f, 0.f, 0.f, 0.f}; }
    const float* Wg = p.in[I_SGW] + (size_t)g * 128 * 128;
#pragma unroll
    for (int ks = 0; ks < 4; ++ks) {
        bf16x8 bfr[2];
#pragma unroll
        for (int n = 0; n < 2; ++n) bfr[n] = tr_frag(vt, 260, 32 * ks, 32 * w + 16 * n, fr, fq);
#pragma unroll
        for (int m = 0; m < 8; ++m) {
            if (m < 4 && ks >= 2) continue;
            const float* wp = Wg + (size_t)(16 * m + fr) * 128 + 32 * ks + 8 * fq; const f32x4 w0 = *(const f32x4*)wp, w1 = *(const f32x4*)(wp + 4);
            const u32x4 aw = pack8(w0, w1); bf16x8 afr; __builtin_memcpy(&afr, &aw, 16);
#pragma unroll
            for (int n = 0; n < 2; ++n) acc[m][n] = __builtin_amdgcn_mfma_f32_16x16x32_bf16(bfr[n], afr, acc[m][n], 0, 0, 0);
        }
    }
    const bf16_t* AU = WSP(bf16_t, WS_AU); bf16_t* YA = WSP(bf16_t, WS_YA);
#pragma unroll
    for (int m = 0; m < 8; ++m) { const float bs = p.in[I_SGB][g * 128 + 16 * m + fr];
#pragma unroll
        for (int n = 0; n < 2; ++n) { const size_t off = (size_t)(row0 + 16 * m + fr) * 2048 + c0 + 32 * w + 16 * n + 4 * fq, offy = off + (size_t)(row0 + 16 * m + fr) * 2048; const u32x2 u = *(const u32x2*)(AU + off);
            u32x2 o; o.x = cvt_pk_bf16(bflo(u.x) * (acc[m][n][0] + bs), bfhi(u.x) * (acc[m][n][1] + bs)); o.y = cvt_pk_bf16(bflo(u.y) * (acc[m][n][2] + bs), bfhi(u.y) * (acc[m][n][3] + bs));
            if (MIX8 & 1) *(unsigned*)((unsigned char*)YA + offy) = cvt4_fp8(bflo(u.x) * (acc[m][n][0] + bs), bfhi(u.x) * (acc[m][n][1] + bs), bflo(u.y) * (acc[m][n][2] + bs), bfhi(u.y) * (acc[m][n][3] + bs));
            else *(u32x2*)(YA + offy) = o; } }
    __syncthreads();
}
__device__ __forceinline__ void prep_unit(const Params& p, LAS unsigned char* lds, int unit) {
    const int tid = threadIdx.x, lane = tid & 63, w = __builtin_amdgcn_readfirstlane(tid >> 6), fr = lane & 15, fq = lane >> 4;
    const int h = unit & 3, r0 = (unit >> 2) * 64;
    LAS float* part = (LAS float*)lds; LAS float* glr = (LAS float*)(lds + 32768); LAS float* tot = (LAS float*)(lds + 36864); LAS float* bl = (LAS float*)(lds + 37888);
    LAS bf16_t* qd = (LAS bf16_t*)(lds + 40960); LAS bf16_t* ki = (LAS bf16_t*)(lds + 40960 + 33792);
    const bf16_t* H = WSP(bf16_t, WS_H); const bf16_t* WG = WSP(bf16_t, WS_WG_T);
    { const bf16_t* Q = WSP(bf16_t, WS_Q); const bf16_t* Kk = WSP(bf16_t, WS_K);
#pragma unroll
      for (int i = 0; i < 4; ++i) { const int idx = tid + 512 * i, row = idx >> 5, ch = idx & 31; const size_t go = (size_t)(r0 + row) * 1024 + h * 256 + 8 * ch;
          const u32x4 qv = *(const u32x4*)(Q + go), kv = *(const u32x4*)(Kk + go); *(LAS u32x4*)(qd + row * 264 + 8 * ch) = qv; *(LAS u32x4*)(ki + row * 264 + 8 * ch) = kv; } }
    { f32x4 ga[4];
#pragma unroll
      for (int m = 0; m < 4; ++m) ga[m] = (f32x4){0.f, 0.f, 0.f, 0.f};
#pragma unroll 2
      for (int ks = 0; ks < 8; ++ks) { const int kk = 256 * w + 32 * ks + 8 * fq; const bf16x8 bfr = *(const bf16x8*)(WG + fr * 2048 + kk);
#pragma unroll
          for (int m = 0; m < 4; ++m) { const bf16x8 afr = *(const bf16x8*)(H + (size_t)(r0 + 16 * m + fr) * 2048 + kk); ga[m] = __builtin_amdgcn_mfma_f32_16x16x32_bf16(afr, bfr, ga[m], 0, 0, 0); } }
#pragma unroll
      for (int m = 0; m < 4; ++m)
#pragma unroll
          for (int r = 0; r < 4; ++r) part[(w * 64 + 16 * m + 4 * fq + r) * 16 + fr] = ga[m][r]; }
    __syncthreads();
    for (int idx = tid; idx < 1024; idx += 512) { float s = 0.f;
#pragma unroll
        for (int ww = 0; ww < 8; ++ww) s += part[ww * 1024 + idx];
        glr[idx] = s; }
    __syncthreads();
    const int kc = tid & 255, half = tid >> 8, kg = h * 256 + kc;
    float cs[32];
    { float w2[16];
#pragma unroll
      for (int j = 0; j < 16; ++j) w2[j] = p.in[I_GW2][j * 1024 + kg];
      const float gb = p.in[I_GGB][kg]; float run = 0.f;
#pragma unroll
      for (int i = 0; i < 32; ++i) { const int t = 32 * half + i; const LAS f32x4* g4 = (const LAS f32x4*)(glr + t * 16); float z = gb;
#pragma unroll
          for (int j = 0; j < 4; ++j) { const f32x4 gv = g4[j]; z += gv[0] * w2[4 * j] + gv[1] * w2[4 * j + 1] + gv[2] * w2[4 * j + 2] + gv[3] * w2[4 * j + 3]; }
          const float ls = fminf(z, 0.f) - __logf(1.0f + __expf(-fabsf(z))); run += ls * 0.0625f; cs[i] = run; }
      if (half == 0) tot[kc] = run;
      __syncthreads();
      const float off = half ? tot[kc] : 0.f;
      if (half == 1) bl[kc] = off + run;
#pragma unroll
      for (int i = 0; i < 32; ++i) cs[i] += off; }
    __syncthreads();
    const float blast = bl[kc];
    { unsigned kst[16];
#pragma unroll
      for (int i = 0; i < 32; i += 2) { float ksv[2];
#pragma unroll
          for (int ii = 0; ii < 2; ++ii) { const int t = 32 * half + i + ii; const float b = cs[i + ii];
              const float q = bf2f(qd[t * 264 + kc]), k = bf2f(ki[t * 264 + kc]); const float eb = __expf(b);
              const float qdv = q * 0.0625f * eb, kiv = k * __builtin_amdgcn_rcpf(eb); ksv[ii] = k * __expf(blast - b);
              qd[t * 264 + kc] = (bf16_t)(cvt_pk_bf16(qdv, 0.f) & 0xffffu); ki[t * 264 + kc] = (bf16_t)(cvt_pk_bf16(kiv, 0.f) & 0xffffu); }
          kst[i >> 1] = cvt_pk_bf16(ksv[0], ksv[1]); }
      u32x4* kd = (u32x4*)(WSP(bf16_t, WS_KST) + ((size_t)unit * 256 + kc) * 64 + 32 * half);
#pragma unroll
      for (int j = 0; j < 4; ++j) kd[j] = (u32x4){kst[4 * j], kst[4 * j + 1], kst[4 * j + 2], kst[4 * j + 3]};
      if (half == 0) WSP(float, WS_DC)[unit * 256 + kc] = __expf(blast); }
    __syncthreads();
    { bf16_t* QD = WSP(bf16_t, WS_QD);
#pragma unroll
      for (int i = 0; i < 4; ++i) { const int idx = tid + 512 * i, row = idx >> 5, ch = idx & 31; *(u32x4*)(QD + (size_t)(r0 + row) * 1024 + h * 256 + 8 * ch) = *(const LAS u32x4*)(qd + row * 264 + 8 * ch); } }
    { const int m = w >> 1, n0 = 2 * (w & 1); f32x4 aa[2] = {(f32x4){0.f, 0.f, 0.f, 0.f}, (f32x4){0.f, 0.f, 0.f, 0.f}};
#pragma unroll
      for (int ks = 0; ks < 8; ++ks) { const bf16x8 afr = *(const LAS bf16x8*)(qd + (16 * m + fr) * 264 + 32 * ks + 8 * fq);
#pragma unroll
          for (int nn = 0; nn < 2; ++nn) { const bf16x8 bfr = *(const LAS bf16x8*)(ki + (16 * (n0 + nn) + fr) * 264 + 32 * ks + 8 * fq);
              aa[nn] = __builtin_amdgcn_mfma_f32_16x16x32_bf16(bfr, afr, aa[nn], 0, 0, 0); } }
      bf16_t* ATT = WSP(bf16_t, WS_ATT);
#pragma unroll
      for (int nn = 0; nn < 2; ++nn) { const int t = 16 * m + fr, s0 = 16 * (n0 + nn) + 4 * fq; float v[4];
#pragma unroll
          for (int r = 0; r < 4; ++r) v[r] = (s0 + r <= t) ? aa[nn][r] : 0.f;
          u32x2 o; o.x = cvt_pk_bf16(v[0], v[1]); o.y = cvt_pk_bf16(v[2], v[3]); *(u32x2*)(ATT + ((size_t)unit * 64 + t) * 64 + s0) = o; } }
    __syncthreads();
}
struct ScanFrags { bf16x8 qf[8]; bf16x8 kf[2][2]; bf16x8 af[2]; f32x4 dcv[2]; u32x4 vraw; };
__device__ __forceinline__ void scan_load(ScanFrags& F, const Params& p, int b, int h, int c, int vc0, int w, int fr, int fq, int tid) {
    const int u = (b * 32 + c) * 4 + h, r0 = b * 2048 + c * 64, rt = w >> 1;
    const bf16_t* QD = WSP(bf16_t, WS_QD) + (size_t)(r0 + 16 * rt + fr) * 1024 + h * 256 + 8 * fq;
#pragma unroll
    for (int ks = 0; ks < 8; ++ks) F.qf[ks] = *(const bf16x8*)(QD + 32 * ks);
    const bf16_t* KST = WSP(bf16_t, WS_KST) + ((size_t)u * 256 + 32 * w + fr) * 64 + 8 * fq;
#pragma unroll
    for (int i = 0; i < 2; ++i)
#pragma unroll
        for (int ks = 0; ks < 2; ++ks) F.kf[i][ks] = *(const bf16x8*)(KST + i * 16 * 64 + 32 * ks);
    const bf16_t* ATT = WSP(bf16_t, WS_ATT) + ((size_t)u * 64 + 16 * rt + fr) * 64 + 8 * fq;
#pragma unroll
    for (int ks = 0; ks < 2; ++ks) F.af[ks] = *(const bf16x8*)(ATT + 32 * ks);
    const float* DC = WSP(float, WS_DC) + u * 256 + 32 * w + 4 * fq;
    F.dcv[0] = *(const f32x4*)DC; F.dcv[1] = *(const f32x4*)(DC + 16);
    F.vraw = *(const u32x4*)(WSP(bf16_t, WS_V) + (size_t)(r0 + (tid >> 3)) * 2048 + vc0 + 8 * (tid & 7));
}
__device__ __forceinline__ void scan_unit(const Params& p, LAS unsigned char* lds, int unit) {
    const int tid = threadIdx.x, lane = tid & 63, w = __builtin_amdgcn_readfirstlane(tid >> 6), fr = lane & 15, fq = lane >> 4;
    const int sl = unit & 7, h = (unit >> 3) & 3, b = unit >> 5, vc0 = h * 512 + sl * 64, rt = w >> 1, cp = w & 1;
    LAS bf16_t* ST = (LAS bf16_t*)lds;
    LAS bf16_t* VT = (LAS bf16_t*)(lds + 67584);
    f32x4 sS[2][4];
#pragma unroll
    for (int i = 0; i < 2; ++i)
#pragma unroll
        for (int n = 0; n < 4; ++n) sS[i][n] = (f32x4){0.f, 0.f, 0.f, 0.f};
    bf16_t* O = WSP(bf16_t, WS_O);
    ScanFrags cur; scan_load(cur, p, b, h, 0, vc0, w, fr, fq, tid);
    for (int c = 0; c < 32; ++c) {
        ScanFrags nx; scan_load(nx, p, b, h, c + 1 < 32 ? c + 1 : 31, vc0, w, fr, fq, tid);
        const int buf = c & 1; LAS bf16_t* st = ST + buf * 16896; LAS bf16_t* vt = VT + buf * 4608;
#pragma unroll
        for (int i = 0; i < 2; ++i)
#pragma unroll
            for (int n = 0; n < 4; ++n) { u32x2 o; o.x = cvt_pk_bf16(sS[i][n][0], sS[i][n][1]); o.y = cvt_pk_bf16(sS[i][n][2], sS[i][n][3]);
                *(LAS u32x2*)(st + (16 * n + fr) * 264 + 32 * w + 16 * i + 4 * fq) = o; }
        *(LAS u32x4*)(vt + (tid >> 3) * 72 + 8 * (tid & 7)) = cur.vraw;
        __syncthreads();
#pragma unroll
        for (int cc = 0; cc < 2; ++cc) { const int ct = 2 * cp + cc;
            f32x4 ao = (f32x4){0.f, 0.f, 0.f, 0.f};
#pragma unroll
            for (int ks = 0; ks < 8; ++ks) { const bf16x8 sfr = *(const LAS bf16x8*)(st + (16 * ct + fr) * 264 + 32 * ks + 8 * fq); ao = __builtin_amdgcn_mfma_f32_16x16x32_bf16(sfr, cur.qf[ks], ao, 0, 0, 0); }
#pragma unroll
            for (int ks = 0; ks < 2; ++ks) ao = __builtin_amdgcn_mfma_f32_16x16x32_bf16(tr_frag(vt, 72, 32 * ks, 16 * ct, fr, fq), cur.af[ks], ao, 0, 0, 0);
            u32x2 o; o.x = cvt_pk_bf16(ao[0], ao[1]); o.y = cvt_pk_bf16(ao[2], ao[3]);
            *(u32x2*)(O + (size_t)(b * 2048 + c * 64 + 16 * rt + fr) * 2048 + vc0 + 16 * ct + 4 * fq) = o; }
#pragma unroll
        for (int n = 0; n < 4; ++n) { bf16x8 vf[2];
#pragma unroll
            for (int ks = 0; ks < 2; ++ks) vf[ks] = tr_frag(vt, 72, 32 * ks, 16 * n, fr, fq);
#pragma unroll
            for (int i = 0; i < 2; ++i) { sS[i][n] = sS[i][n] * cur.dcv[i];
#pragma unroll
                for (int ks = 0; ks < 2; ++ks) sS[i][n] = __builtin_amdgcn_mfma_f32_16x16x32_bf16(cur.kf[i][ks], vf[ks], sS[i][n], 0, 0, 0); } }
        cur = nx;
    }
    __syncthreads();
}
__device__ __forceinline__ void p5_yb(const Params& p) {
    const int tid = threadIdx.x, lane = tid & 63, wave = tid >> 6, gw = blockIdx.x * NWAVES + wave, NGW = gridDim.x * NWAVES;
    const f32x4 g0 = *(const f32x4*)(p.in[I_GNG] + 8 * lane), g1 = *(const f32x4*)(p.in[I_GNG] + 8 * lane + 4);
    for (int m = gw; m < NTOK; m += NGW) {
#pragma unroll
        for (int hh = 0; hh < 4; ++hh) { const size_t off = (size_t)m * 2048 + hh * 512 + 8 * lane;
            const u32x4 o = *(const u32x4*)(WSP(bf16_t, WS_O) + off), r = *(const u32x4*)(WSP(bf16_t, WS_R) + off);
            float v[8] = {bflo(o.x), bfhi(o.x), bflo(o.y), bfhi(o.y), bflo(o.z), bfhi(o.z), bflo(o.w), bfhi(o.w)};
            float s = 0.f;
#pragma unroll
            for (int j = 0; j < 8; ++j) s += v[j] * v[j];
            const float rstd = rsqrtf(wave_sum(s) * (1.0f / 512.0f) + EPS);
            const float rr[8] = {bflo(r.x), bfhi(r.x), bflo(r.y), bfhi(r.y), bflo(r.z), bfhi(r.z), bflo(r.w), bfhi(r.w)};
            f32x4 y0, y1;
#pragma unroll
            for (int j = 0; j < 4; ++j) { y0[j] = v[j] * rstd * g0[j] * rr[j]; y1[j] = v[4 + j] * rstd * g1[j] * rr[4 + j]; }
            if (MIX8 & 1) { u32x2 w8; w8.x = cvt4_fp8(y0[0], y0[1], y0[2], y0[3]); w8.y = cvt4_fp8(y1[0], y1[1], y1[2], y1[3]); *(u32x2*)(WSP(unsigned char, WS_YA) + (size_t)m * 4096 + 2048 + hh * 512 + 8 * lane) = w8; }
            else *(u32x4*)(WSP(bf16_t, WS_YA) + (size_t)m * 4096 + 2048 + hh * 512 + 8 * lane) = pack8(y0, y1); }
    }
}
__device__ __forceinline__ void router_item(const Params& p, LAS unsigned char* lds, int item) {
    const int tid = threadIdx.x, lane = tid & 63, w = __builtin_amdgcn_readfirstlane(tid >> 6);
    const int R0 = item * 32, b = R0 >> 11;
    LAS float* pl = (LAS float*)lds; LAS float* sq = (LAS float*)(lds + 32768); LAS float* lg = (LAS float*)(lds + 33792); LAS float* rs = (LAS float*)(lds + 38400);
    LAS int* lcnt = (LAS int*)(lds + 38656); LAS int* lbase = (LAS int*)(lds + 38912);
    if (tid < 32) lcnt[tid] = 0;
    const float* X1 = WSP(float, WS_X1);
    { f32x16 acc;
#pragma unroll
      for (int i = 0; i < 16; ++i) acc[i] = 0.f;
      float ssq = 0.f; const int row = lane & 31, hi = lane >> 5;
      const float* xr = X1 + (size_t)(R0 + row) * 2048 + 256 * w + 4 * hi;
      const float* br = WSP(float, WS_RWP) + (size_t)b * 65536 + (size_t)(256 * w + 4 * hi) * 32 + row;
#pragma unroll 4
      for (int kb = 0; kb < 256; kb += 8) { const f32x4 va = *(const f32x4*)(xr + kb); ssq += (va[0] * va[0] + va[1] * va[1]) + (va[2] * va[2] + va[3] * va[3]);
#pragma unroll
          for (int j = 0; j < 4; ++j) acc = __builtin_amdgcn_mfma_f32_32x32x2f32(va[j], br[(kb + j) * 32], acc, 0, 0, 0); }
      ssq += __shfl_xor(ssq, 32);
      if (lane < 32) sq[w * 32 + lane] = ssq;
#pragma unroll
      for (int r = 0; r < 16; ++r) pl[(w * 32 + (r & 3) + 8 * (r >> 2) + 4 * hi) * 32 + row] = acc[r]; }
    __syncthreads();
#pragma unroll
    for (int q = 0; q < 2; ++q) { const int idx = tid + 512 * q, r = idx >> 5, e = idx & 31; float s = 0.f, ss = 0.f;
#pragma unroll
        for (int ww = 0; ww < 8; ++ww) { s += pl[ww * 1024 + idx]; ss += sq[ww * 32 + r]; }
        const float rstd = rsqrtf(ss * (1.0f / 2048.0f) + EPS); lg[r * 33 + e] = s * rstd + WSP(float, WS_BIASP)[b * 32 + e]; if (e == 0) rs[r] = rstd; }
    __syncthreads();
    int ek[4] = {0, 0, 0, 0}, rk[4] = {0, 0, 0, 0}; float wk[4] = {0.f, 0.f, 0.f, 0.f};
    if (tid < 32) { unsigned taken = 0u; float lv[4];
#pragma unroll
        for (int k = 0; k < 4; ++k) { float best = -3.0e38f; int bi = 0;
            for (int e = 0; e < 32; ++e) { const float x = lg[tid * 33 + e]; if (!((taken >> e) & 1u) && x > best) { best = x; bi = e; } }
            taken |= 1u << bi; ek[k] = bi; lv[k] = best; }
        float sum = 0.f;
#pragma unroll
        for (int k = 0; k < 4; ++k) { wk[k] = expf(lv[k] - lv[0]); sum += wk[k]; }
#pragma unroll
        for (int k = 0; k < 4; ++k) { wk[k] /= sum; rk[k] = __hip_atomic_fetch_add(&lcnt[ek[k]], 1, __ATOMIC_RELAXED, __HIP_MEMORY_SCOPE_WORKGROUP); } }
    __syncthreads();
    if (tid < 32) { const int c = lcnt[tid]; lbase[tid] = c ? (int)__hip_atomic_fetch_add((unsigned*)WSP(unsigned, WS_CTL) + CW_CNT + tid, (unsigned)c, __ATOMIC_RELAXED, __HIP_MEMORY_SCOPE_AGENT) : 0; }
    __syncthreads();
    if (tid < 32) {
#pragma unroll
        for (int k = 0; k < 4; ++k) { const int pos = lbase[ek[k]] + rk[k], slot = (R0 + tid) * 4 + k; WSP(int, WS_LIST)[ek[k] * 8192 + pos] = slot; WSP(float, WS_TOPW)[slot] = wk[k]; } }
    const float* MOD = WSP(float, WS_MOD) + b * 12288;
#pragma unroll
    for (int rr = 0; rr < 4; ++rr) { const int r = 4 * w + rr; const float rstd = rs[r]; const size_t ro = (size_t)(R0 + r) * 2048;
#pragma unroll
        for (int j = 0; j < 4; ++j) { const int c = 8 * lane + 512 * j; f32x4 o[2];
#pragma unroll
            for (int q = 0; q < 2; ++q) { const f32x4 x = *(const f32x4*)(X1 + ro + c + 4 * q), g = *(const f32x4*)(p.in[I_N2G] + c + 4 * q), sc = *(const f32x4*)(MOD + 4 * 2048 + c + 4 * q), sh = *(const f32x4*)(MOD + 3 * 2048 + c + 4 * q);
                o[q] = x * rstd * g * (sc + 1.0f) + sh; }
            u32x2 w8; w8.x = cvt4_fp8(o[0][0], o[0][1], o[0][2], o[0][3]); w8.y = cvt4_fp8(o[1][0], o[1][1], o[1][2], o[1][3]); *(u32x2*)(WSP(unsigned char, WS_H) + ro + c) = w8; } }
    __syncthreads();
}
__device__ __forceinline__ int moe_tables(const Params& p, LAS int* tab) {
    const int tid = threadIdx.x;
    if (tid < 32) tab[tid] = (int)__hip_atomic_load((unsigned*)WSP(unsigned, WS_CTL) + CW_CNT + tid, __ATOMIC_RELAXED, __HIP_MEMORY_SCOPE_AGENT);
    __syncthreads();
    if (tid == 0) { int a = 0; for (int e = 0; e < 32; ++e) { tab[32 + e] = a; const int n = (tab[e] + 255) >> 8; for (int j = 0; j < n; ++j) tab[72 + a + j] = e; a += n; } tab[64] = a; }
    __syncthreads();
    return tab[64];
}
__device__ __forceinline__ void p11_final(const Params& p) {
    const int tid = threadIdx.x, lane = tid & 63, wave = tid >> 6, gw = blockIdx.x * NWAVES + wave, NGW = gridDim.x * NWAVES;
    const float* X1 = WSP(float, WS_X1); const bf16_t* Y = WSP(bf16_t, WS_Y); const float* TW = WSP(float, WS_TOPW);
    for (int m = gw; m < NTOK; m += NGW) {
        const int b = m >> 11; const float* gt2 = WSP(float, WS_MOD) + b * 12288 + 5 * 2048;
        const f32x4 wk = *(const f32x4*)(TW + 4 * m);
        f32x4 x2[4][2]; float s = 0.f;
#pragma unroll
        for (int j = 0; j < 4; ++j) { const int c = 8 * lane + 512 * j; f32x4 mo[2] = {(f32x4){0.f, 0.f, 0.f, 0.f}, (f32x4){0.f, 0.f, 0.f, 0.f}};
#pragma unroll
            for (int k = 0; k < 4; ++k) { const u32x4 y = *(const u32x4*)(Y + ((size_t)m * 4 + k) * 2048 + c); const float wv = wk[k];
                mo[0][0] += wv * bflo(y.x); mo[0][1] += wv * bfhi(y.x); mo[0][2] += wv * bflo(y.y); mo[0][3] += wv * bfhi(y.y);
                mo[1][0] += wv * bflo(y.z); mo[1][1] += wv * bfhi(y.z); mo[1][2] += wv * bflo(y.w); mo[1][3] += wv * bfhi(y.w); }
#pragma unroll
            for (int q = 0; q < 2; ++q) { const f32x4 x = *(const f32x4*)((DBG_MODE == 1 ? p.in[I_X] : X1) + (size_t)m * 2048 + c + 4 * q), g = *(const f32x4*)(gt2 + c + 4 * q); const f32x4 v = (DBG_MODE == 0) ? x + g * mo[q] : x; x2[j][q] = v;
                s += (v[0] * v[0] + v[1] * v[1]) + (v[2] * v[2] + v[3] * v[3]); } }
        const float rstd = rsqrtf(wave_sum(s) * (1.0f / 2048.0f) + EPS);
#pragma unroll
        for (int j = 0; j < 4; ++j)
#pragma unroll
            for (int q = 0; q < 2; ++q) { const int c = 8 * lane + 512 * j + 4 * q; *(f32x4*)(p.out + (size_t)m * 2048 + c) = x2[j][q] * rstd * *(const f32x4*)(p.in[I_FG] + c); }
    }
}


__device__ __forceinline__ void dbg_out(const Params& p, int mode) {
    const size_t n = (size_t)NTOK * 2048;
    for (size_t i = (size_t)blockIdx.x * 512 + threadIdx.x; i < n; i += (size_t)gridDim.x * 512) {
        const size_t m = i >> 11, c = i & 2047; float v = 0.f;
        if (mode == 3) v = bf2f(WSP(bf16_t, WS_H)[i]) + WSP(float, WS_MOD)[i % 49152] + WSP(float, WS_RWP)[i % 262144] + bf2f(WSP(bf16_t, WS_WIN_T)[i]) + bf2f(WSP(bf16_t, WS_WA_T)[i % 4194304]) + bf2f(WSP(bf16_t, WS_WG_T)[i % 32768]);
        if (mode == 4) v = bf2f(WSP(bf16_t, WS_AU)[i]) + bf2f(WSP(bf16_t, WS_AV)[i]) + bf2f(WSP(bf16_t, WS_V)[i]) + bf2f(WSP(bf16_t, WS_R)[i]) + bf2f(WSP(bf16_t, WS_GA)[i]) + bf2f(WSP(bf16_t, WS_GB)[i]) + bf2f(WSP(bf16_t, WS_Q)[m * 1024 + (c & 1023)]) + bf2f(WSP(bf16_t, WS_K)[m * 1024 + (c & 1023)]) + WSP(float, WS_LNP)[i % 524288];
        if (mode == 5) v = bf2f(WSP(bf16_t, WS_YA)[i]);
        if (mode == 6) v = bf2f(WSP(bf16_t, WS_QD)[i % 8388608]) + bf2f(WSP(bf16_t, WS_KST)[i % 8388608]) + bf2f(WSP(bf16_t, WS_ATT)[i % 2097152]) + WSP(float, WS_DC)[i % 131072];
        if (mode == 7) v = bf2f(WSP(bf16_t, WS_O)[i]);
        if (mode == 8) v = bf2f(WSP(bf16_t, WS_YB)[i]) + WSP(float, WS_M1)[i];
        if (mode == 9) v = bf2f(WSP(bf16_t, WS_MERGED)[i]);
        p.out[i] = v;
    }
}

constexpr int PER_PHASE = 12;
constexpr int N_LAUNCHES = MK_N_LAUNCHES;
__global__ void __launch_bounds__(NWAVES * 64, 2) fwd_kernel(Params p) {
    extern __shared__ __attribute__((aligned(16))) unsigned char lds_raw[];
    LAS unsigned char* lds = (LAS unsigned char*)lds_raw;
    const int tid = threadIdx.x, G = gridDim.x;
    for (int u = tid; u < (TAB_OFF - LDSCTL_OFF) / 4; u += NWAVES * 64) ((LAS unsigned*)(lds + LDSCTL_OFF))[u] = 0u;
    __syncthreads();
    unsigned* ctl = WSP(unsigned, WS_CTL);
    XcdBarrier bar; bar.bar = ctl + CW_BAR; bar.x = 0; bar.st = nullptr;
    if (N_LAUNCHES == 1) bar = xcd_barrier_post(ctl + CW_BAR, (volatile LAS unsigned*)(lds + MISC_OFF) + 8);
    const int lo = p.ph_lo, hi = p.ph_hi;
#define IN(k) (lo <= (k) && (k) < hi)
#define SEAM(k) do { if (IN(k) && IN((k) + 1)) xcd_barrier(bar); } while (0)

    if (IN(0)) { p0_prologue(p, lds); }
    SEAM(0);
    if (IN(1)) { p1_norm1(p); }
    SEAM(1);
    if (IN(2)) {
        if (PROJ8_PN0 > 0) { DenseSched S; S.o.init(NTOK / 256, PROJ8_PN0, G, blockIdx.x); S.A = (const char*)WSP(bf16_t, WS_H); S.Bt = (const char*)WSP(bf16_t, WS_WIN_T); S.K = 2048;
            EpiProj E{p.ws, false}; pg8::gemm_phase<EpiProj, DenseSched>(lds, S, E, 2048); }
        if (PROJ8_PN0 < 56) { DenseSched8 S; S.o.init(NTOK / 256, 56 - PROJ8_PN0, G, blockIdx.x); S.A = (const char*)WSP(unsigned char, WS_H8); S.Bt = (const char*)WSP(unsigned char, WS_WIN8); S.K = 2048; S.pn0 = PROJ8_PN0;
            EpiProj E{p.ws, true}; pg8::gemm_phase<EpiProj, DenseSched8>(lds, S, E, 2048); }
    }
    SEAM(2);
    if (IN(3)) {
        if (G == 256) { const int x = blockIdx.x & 7, sidx = blockIdx.x >> 3;
            for (int i = 0; i < 2; ++i) { const int j = sidx * 2 + i; prep_unit(p, lds, ((((x >> 1) * 32 + (j >> 1)) << 2) | (2 * (x & 1) + (j & 1)))); } }
        else for (int u = blockIdx.x; u < 512; u += G) prep_unit(p, lds, u);
    }
    SEAM(3);
    if (IN(4)) {
        const int half = G >> 1, x = blockIdx.x & 7, sidx = blockIdx.x >> 3;
        if (G == 256) {
            if (!(sidx & 1)) { const int s16 = sidx >> 1; for (int r_ = 0; r_ < REP_SCAN; ++r_) scan_unit(p, lds, ((x * 2 + (s16 >> 3)) << 3) | (s16 & 7)); }
            else { const int j = (sidx >> 1) * 8 + x; for (int r_ = 0; r_ < REP_SG; ++r_) for (int u = j; u < 512; u += half) sg_unit(p, lds, u); }
        } else { for (int u = blockIdx.x; u < 128; u += G) scan_unit(p, lds, u); for (int u = blockIdx.x; u < 512; u += G) sg_unit(p, lds, u); }
    }
    SEAM(4);
    if (IN(5)) { p5_yb(p); }
    SEAM(5);
    if (IN(6)) {
        SchedM S; S.o.init(NTOK / 256, 8, G, blockIdx.x); S.A = (const char*)WSP(bf16_t, WS_YA); S.Bt = (const char*)WSP(bf16_t, WS_WA_T); S.K = 4096;
        EpiMerge E{WSP(bf16_t, WS_GA), WSP(bf16_t, WS_GB), WSP(bf16_t, WS_MERGED)};
        pg8::gemm_phase<EpiMerge, SchedM>(lds, S, E, 4096);
    }
    SEAM(6);
    if (IN(7)) {
        SchedO S; S.o.init(NTOK / 256, 8, G, blockIdx.x); S.A = (const char*)WSP(bf16_t, WS_MERGED); S.Bt = (const char*)WSP(bf16_t, WS_WOUT_T); S.K = 2048;
        EpiOut E{p.in[I_X], WSP(float, WS_MOD), WSP(float, WS_X1)};
        pg8::gemm_phase<EpiOut, SchedO>(lds, S, E, 2048);
    }
    SEAM(7);
    if (IN(8)) { for (int it = blockIdx.x; it < NTOK / 32; it += G) router_item(p, lds, it); }
    SEAM(8);
    if (IN(9)) {
        LAS int* tab = (LAS int*)(lds + TAB_OFF); LAS unsigned* goff = (LAS unsigned*)(lds + TAB_OFF + 1024);
        const int NT = moe_tables(p, tab);
        Moe1Sched S; S.o.init(NT, 16, G, blockIdx.x); S.A = (const char*)WSP(bf16_t, WS_H); S.W = (const char*)WSP(bf16_t, WS_WGU_T); S.tab = tab; S.goff = goff;
        for (int i = 0; i < 10; ++i) { int pm, pn; if (!S.o.idx(i, pm, pn)) break; const int e = tab[72 + pm], rt = pm - tab[32 + e], cnt = tab[e];
            for (int r = tid; r < 256; r += NWAVES * 64) { const int pos = rt * 256 + r; const int tok = pos < cnt ? (WSP(int, WS_LIST)[e * 8192 + pos] >> 2) : 0; goff[i * 256 + r] = (unsigned)tok * 2048u; } }
        __syncthreads();
        EpiAct E{p.in[I_EBG], p.in[I_EBU], WSP(bf16_t, WS_ACT)};
        pg8::gemm_phase<EpiAct, Moe1Sched>(lds, S, E, 2048);
    }
    SEAM(9);
    if (IN(10)) {
        LAS int* tab = (LAS int*)(lds + TAB_OFF);
        const int NT = moe_tables(p, tab);
        Moe2Sched S; S.o.init(NT, 8, G, blockIdx.x); S.A = (const char*)WSP(bf16_t, WS_ACT); S.W = (const char*)WSP(bf16_t, WS_WDN_T); S.tab = tab;
        EpiDown E{p.in[I_EBD], WSP(bf16_t, WS_Y), WSP(int, WS_LIST), tab};
        pg8::gemm_phase<EpiDown, Moe2Sched>(lds, S, E, 2048);
    }
    SEAM(10);
    if (IN(11)) { if (DBG_MODE >= 3) dbg_out(p, DBG_MODE); else p11_final(p); }
#undef IN
#undef SEAM
}

extern "C" void kernel_launch(void* const* d_in, const int* in_sizes, int n_in, void* d_out, int out_size, void* d_ws, size_t ws_size, hipStream_t stream) {
    static int grid = 0;
    if (grid == 0) {
        if (n_in != 26 || out_size != NTOK * DM || ws_size < WS_END) { fprintf(stderr, "kernel_launch: unexpected shapes (n_in %d, out %d, ws %zu); nothing launched\n", n_in, out_size, ws_size); grid = -1; return; }
        int dev = 0, cus = 0, per_cu = 0;
        if (hipGetDevice(&dev) != hipSuccess || hipDeviceGetAttribute(&cus, hipDeviceAttributeMultiprocessorCount, dev) != hipSuccess) { grid = -1; return; }
        if (hipFuncSetAttribute((const void*)fwd_kernel, hipFuncAttributeMaxDynamicSharedMemorySize, LDS_BYTES) != hipSuccess) { fprintf(stderr, "kernel_launch: hipFuncSetAttribute failed\n"); grid = -1; return; }
        if (hipOccupancyMaxActiveBlocksPerMultiprocessor(&per_cu, (const void*)fwd_kernel, NWAVES * 64, LDS_BYTES) != hipSuccess || per_cu < 1) { fprintf(stderr, "kernel_launch: occupancy query says %d blocks per CU\n", per_cu); }
        (void)hipGetLastError();
        grid = cus;
    }
    if (grid < 0) return;
    if (hipMemsetAsync((char*)d_ws + WS_CTL, 0, CTL_ZERO_BYTES, stream) != hipSuccess) return;
    Params a{};
    for (int i = 0; i < 26; ++i) a.in[i] = (const float*)d_in[i];
    a.out = (float*)d_out; a.ws = (unsigned char*)d_ws;
    for (int li = 0; li < N_LAUNCHES; ++li) {
        if (DBG_MODE == 1 && li != 11) continue;
        if (DBG_MODE == 2 && li >= 8 && li != 11) continue;
        { const int lastph[10] = {11, 11, 7, 1, 2, 3, 3, 4, 5, 6}; if (DBG_MODE >= 3 && li > lastph[DBG_MODE] && li != 11) continue; }
        a.ph_lo = (N_LAUNCHES == 1) ? 0 : li; a.ph_hi = (N_LAUNCHES == 1) ? PER_PHASE : li + 1; a.li = li; a.pad = 0;
        for (int rep_ = 0; rep_ <= ((REPEAT_MASK >> li) & 1); ++rep_) {
            if (rep_ && li == 8) (void)hipMemsetAsync((char*)d_ws + WS_CTL + CW_CNT * 4, 0, 128, stream);
        hipLaunchKernelGGL(fwd_kernel, dim3(grid), dim3(NWAVES * 64), LDS_BYTES, stream, a);
        }
        const hipError_t le = hipPeekAtLastError();
        if (le != hipSuccess) { fprintf(stderr, "kernel_launch: launch %d failed: %s\n", li, hipGetErrorName(le)); break; }
    }
}
```

```cpp
#include <hip/hip_runtime.h>
#include <cstdio>
#include <cstdint>

#ifndef DBG_MODE
#define DBG_MODE 0
#endif
#ifndef REPEAT_MASK
#define REPEAT_MASK 0
#endif
#ifndef REP_SCAN
#define REP_SCAN 1
#endif
#ifndef REP_SG
#define REP_SG 1
#endif
#ifndef PROJ8_PN0
#define PROJ8_PN0 0
#endif
#ifndef MIX8
#define MIX8 1
#endif
#ifndef MK_N_LAUNCHES
#define MK_N_LAUNCHES 1
#endif

#define LAS __attribute__((address_space(3)))
#define GAS __attribute__((address_space(1)))
typedef unsigned short bf16_t;
typedef short bf16x8 __attribute__((ext_vector_type(8)));
typedef float f32x4 __attribute__((ext_vector_type(4)));
typedef float f32x2 __attribute__((ext_vector_type(2)));
typedef float f32x16 __attribute__((ext_vector_type(16)));
typedef unsigned u32x4 __attribute__((ext_vector_type(4)));
typedef unsigned u32x2 __attribute__((ext_vector_type(2)));
typedef int i32x4 __attribute__((ext_vector_type(4)));
typedef int i32x8 __attribute__((ext_vector_type(8)));
typedef GAS unsigned gu32;
#define RLX_AGENT __ATOMIC_RELAXED, __HIP_MEMORY_SCOPE_AGENT

constexpr int DM = 2048, NB = 4, SEQ = 2048, NTOK = NB * SEQ;
constexpr int NPROJ = 14336;
constexpr int INW = 14352;
constexpr int NEXP = 32, TOPK = 4, NSLOT = NTOK * TOPK;
constexpr int MAXTILE = 160;
constexpr float EPS = 1e-6f;

constexpr size_t MiB = 1u << 20;
constexpr size_t WS_CTL = 0, CTL_ZERO_BYTES = 128 * 1024;
constexpr size_t WS_MOD = 2 * MiB;
constexpr size_t WS_RWP = 3 * MiB;
constexpr size_t WS_BIASP = 4 * MiB;
constexpr size_t WS_WG_T = 4 * MiB + 4096;
constexpr size_t WS_LNP = 5 * MiB;
constexpr size_t WS_DC = 7 * MiB;
constexpr size_t WS_TOPW = 8 * MiB;
constexpr size_t WS_LIST = 9 * MiB;
constexpr size_t WS_WIN_T = 16 * MiB;
constexpr size_t WS_WA_T = 72 * MiB, WS_WB_T = 80 * MiB, WS_WOUT_T = 88 * MiB;
constexpr size_t WS_WGU_T = 96 * MiB;
constexpr size_t WS_WDN_T = 608 * MiB;
constexpr size_t WS_H = 864 * MiB;
constexpr size_t WS_AU = 896 * MiB, WS_AV = 928 * MiB, WS_Q = 960 * MiB, WS_K = 976 * MiB, WS_V = 992 * MiB, WS_R = 1024 * MiB, WS_GA = 1056 * MiB, WS_GB = 1088 * MiB;
constexpr size_t WS_QD = 1120 * MiB, WS_KST = 1136 * MiB, WS_ATT = 1152 * MiB;
constexpr size_t WS_O = 1160 * MiB, WS_YA = 1192 * MiB, WS_YB = 1224 * MiB, WS_MERGED = 1256 * MiB, WS_X1 = 1288 * MiB, WS_M1 = 1352 * MiB;
constexpr size_t WS_H8 = WS_M1;
constexpr size_t WS_WIN8 = WS_M1 + 16 * MiB;
constexpr size_t WS_HS = 10 * MiB;
constexpr size_t WS_WS = 10 * MiB + 65536;
constexpr int CW_CMAX = 16384;
constexpr size_t WS_ACT = 1416 * MiB;
constexpr size_t WS_Y = 1576 * MiB;
constexpr size_t WS_END = 1704 * MiB;
constexpr int CW_TMO = 0, CW_CODE = 1, CW_CNT = 64, CW_BAR = 4096;

constexpr int RING_BYTES = 131072;
constexpr int LDSCTL_OFF = RING_BYTES, MISC_OFF = LDSCTL_OFF + 320;
constexpr int TAB_OFF = RING_BYTES + 1024;
constexpr int LDS_BYTES = 147456;

typedef __bf16 bf16x2_t __attribute__((ext_vector_type(2)));
__device__ __forceinline__ unsigned cvt_pk_bf16(float lo, float hi) { const f32x2 v = {lo, hi}; const bf16x2_t b = __builtin_convertvector(v, bf16x2_t); unsigned r; __builtin_memcpy(&r, &b, 4); return r; }
__device__ __forceinline__ float bf2f(unsigned short b) { return __uint_as_float(((unsigned)b) << 16); }
__device__ __forceinline__ float bflo(unsigned w) { return __uint_as_float(w << 16); }
__device__ __forceinline__ float bfhi(unsigned w) { return __uint_as_float(w & 0xffff0000u); }
__device__ __forceinline__ float fast_sigmoid(float x) { return __builtin_amdgcn_rcpf(1.0f + __expf(-x)); }
__device__ __forceinline__ float gelu_tanh(float x) { const float u = 0.7978845608f * (x + 0.044715f * x * x * x); return x * fast_sigmoid(2.0f * u); }
__device__ __forceinline__ float wave_sum(float v) {
#pragma unroll
    for (int o = 1; o < 64; o <<= 1) v += __shfl_xor(v, o);
    return v;
}

typedef short s16x4 __attribute__((ext_vector_type(4)));
__device__ __forceinline__ bf16x8 tr_frag(const LAS bf16_t* tile, int pitch, int row0, int col0, int fr, int fq) {
    const LAS bf16_t* a = tile + (row0 + 8 * fq + (fr >> 2)) * pitch + col0 + 4 * (fr & 3);
    const s16x4 lo = __builtin_amdgcn_ds_read_tr16_b64_v4i16((LAS s16x4*)a), hi = __builtin_amdgcn_ds_read_tr16_b64_v4i16((LAS s16x4*)(a + 4 * pitch));
    return (bf16x8){lo[0], lo[1], lo[2], lo[3], hi[0], hi[1], hi[2], hi[3]};
}

__device__ __forceinline__ unsigned cvt4_fp8(float a, float b, float c, float d) { int w = __builtin_amdgcn_cvt_pk_fp8_f32(a, b, 0, false); w = __builtin_amdgcn_cvt_pk_fp8_f32(c, d, w, true); return (unsigned)w; }
constexpr float W8_SCALE = 64.0f, W8_INV = 1.0f / 64.0f;
#define LDS_WAIT() asm volatile("s_waitcnt lgkmcnt(0)" ::: "memory")
#define VM_WAIT() asm volatile("s_waitcnt vmcnt(0)" ::: "memory")

#define XB_TMO      128
#define XB_XCNT(j)  (256  + 64 * (j))
#define XB_XSUB(j)  (1280 + 64 * (j))
#define XB_XGEN(j)  (2304 + 64 * (j))
#define XB_TOP      3328
#define XB_TOPGEN   3392
#define XCD_BAR_WORDS 3456
#define XB_SPIN_CAP (1u << 18)
__device__ __forceinline__ unsigned xb_ld(unsigned* p)              { return __hip_atomic_load(p, __ATOMIC_RELAXED, __HIP_MEMORY_SCOPE_AGENT); }
__device__ __forceinline__ unsigned xb_add(unsigned* p, unsigned v) { return __hip_atomic_fetch_add(p, v, __ATOMIC_RELAXED, __HIP_MEMORY_SCOPE_AGENT); }
__device__ __forceinline__ unsigned xb_xcc_id() { return (unsigned)__builtin_amdgcn_s_getreg((3 << 11) | 20) & 0xFu; }
#define XB_SPIN(cond, bar) do { unsigned _sp = 0; while (cond) { __builtin_amdgcn_s_sleep(1); \
    if ((++_sp & 255u) == 0u) { if (xb_ld(&(bar)[XB_TMO])) break; if (_sp > XB_SPIN_CAP) { atomicAdd(&(bar)[XB_TMO], 1u); break; } } } } while (0)
struct XcdBarrier { unsigned* bar; unsigned x; volatile LAS unsigned* st; };
__device__ __forceinline__ XcdBarrier xcd_barrier_post(unsigned* bar, volatile LAS unsigned* st) {
    XcdBarrier b; b.bar = bar; b.x = xb_xcc_id(); b.st = st;
    if (threadIdx.x == 0) (void)xb_add(&bar[XB_XCNT(b.x)], 1u);
    return b;
}
__device__ __forceinline__ void xcd_barrier_complete(unsigned* bar, unsigned x, unsigned& nloc, unsigned& nx) {
    const unsigned G = gridDim.x * gridDim.y * gridDim.z;
    unsigned sum, cnt, mine, sp = 0u;
    for (;;) {
        sum = 0u; cnt = 0u; mine = 0u;
#pragma unroll
        for (unsigned j = 0; j < 16; ++j) { const unsigned c = xb_ld(&bar[XB_XCNT(j)]); sum += c; cnt += (c > 0u) ? 1u : 0u; mine = (j == x) ? c : mine; }
        if (sum == G) break;
        __builtin_amdgcn_s_sleep(1);
        if ((++sp & 255u) == 0u) { if (xb_ld(&bar[XB_TMO])) break; if (sp > XB_SPIN_CAP) { atomicAdd(&bar[XB_TMO], 1u); break; } }
    }
    nloc = mine > 0u ? mine : 1u; nx = cnt > 0u ? cnt : 1u;
}
__device__ __forceinline__ void xcd_barrier(const XcdBarrier& b) {
    asm volatile("s_waitcnt vmcnt(0)" ::: "memory");
    __syncthreads();
    if (threadIdx.x == 0) {
        unsigned* bar = b.bar;
        __builtin_amdgcn_s_waitcnt(0);
        unsigned nloc = b.st[0], nx = b.st[1];
        if (nloc == 0u) { xcd_barrier_complete(bar, b.x, nloc, nx); b.st[0] = nloc; b.st[1] = nx; }
        const unsigned old = xb_add(&bar[XB_XSUB(b.x)], 1u);
        const unsigned gen = old / nloc;
        if (old + 1u == (gen + 1u) * nloc) {
            __builtin_amdgcn_fence(__ATOMIC_RELEASE, "agent");
            asm volatile("s_waitcnt vmcnt(0)" ::: "memory");
            const unsigned og = xb_add(&bar[XB_TOP], 1u);
            const unsigned tg = og / nx;
            if (og + 1u == (tg + 1u) * nx) xb_add(&bar[XB_TOPGEN], 1u);
            else XB_SPIN(xb_ld(&bar[XB_TOPGEN]) == tg, bar);
            __builtin_amdgcn_fence(__ATOMIC_ACQUIRE, "agent");
            xb_add(&bar[XB_XGEN(b.x)], 1u);
            asm volatile("s_waitcnt vmcnt(0)" ::: "memory");
        } else {
            XB_SPIN(xb_ld(&bar[XB_XGEN(b.x)]) == gen, bar);
            __builtin_amdgcn_fence(__ATOMIC_ACQUIRE, "agent");
            asm volatile("s_waitcnt vmcnt(0)" ::: "memory");
        }
    }
    __syncthreads();
}

typedef f32x4 Acc[2][2][4][2];
namespace pg8 {
constexpr int BM = 256, BK = 64, HALF = 128, HTB = HALF * BK * 2, NXCD = 8, WGM = 8;
__host__ __device__ __forceinline__ int lds_byte(int r, int c) { const int st = (r >> 4) * 2 + (c >> 5), rr = r & 15, cc = c & 31, ob = rr * 64 + cc * 2; return st * 1024 + (ob ^ (((ob >> 9) & 1) << 5)); }
__host__ __device__ __forceinline__ void stage_rc(int b, int& R, int& C) { const int st = b / 1024, sb = b % 1024, swz = sb ^ (((sb >> 9) & 1) << 5); R = (st >> 1) * 16 + swz / 64; C = (st & 1) * 32 + (swz % 64) / 2; }
__host__ __device__ __forceinline__ int perm32(int rho) { const int n = rho >> 4, i = rho & 15; return 8 * (i >> 2) + 4 * n + (i & 3); }

struct Unit { int pm, pn, e; };
struct Order {
    int nM, nN, nwg, G, c;
    __device__ __forceinline__ void init(int nM_, int nN_, int G_, int c_) { nM = nM_; nN = nN_; nwg = nM * nN; G = G_; c = c_; }
    __device__ __forceinline__ bool idx(int i, int& pm, int& pn) const {
        const long L = (long)i * G + c; if (L >= nwg) return false;
        int wgid = (int)L; { const int q = nwg / NXCD, r = nwg % NXCD, xcd = wgid % NXCD, off = wgid / NXCD; wgid = (xcd < r ? xcd * (q + 1) : r * (q + 1) + (xcd - r) * q) + off; }
        const int nig = WGM * nN, gid = wgid / nig, fm = gid * WGM, gsz = (nM - fm) < WGM ? (nM - fm) : WGM;
        pm = fm + ((wgid % nig) % gsz); pn = (wgid % nig) / gsz; return true;
    }
};

template <class Epi, class Sched>
__device__ __forceinline__ void gemm_phase(LAS unsigned char* lds, const Sched& S, const Epi& E, const int K) {
    const int tid = threadIdx.x, wid = __builtin_amdgcn_readfirstlane(tid >> 6), lane = tid & 63, wr = wid >> 2, wc = wid & 3, fr = lane & 15, fq = lane >> 4;
    constexpr bool I8 = Sched::I8;
    constexpr bool FP8 = Sched::FP8;
    const int nt = (FP8 || I8) ? K / 128 : K / BK; const int pitch = (FP8 || I8) ? K : 2 * K;
    int Rr[2], Cc[2]; unsigned voffA[2], voffB[2];
#pragma unroll
    for (int i = 0; i < 2; ++i) { stage_rc(tid * 16 + i * 8192, Rr[i], Cc[i]); const int Rb = Epi::PERM ? ((Rr[i] & ~31) + perm32(Rr[i] & 31)) : Rr[i];
        voffA[i] = (unsigned)(Rr[i] * pitch + Cc[i] * 2); voffB[i] = (unsigned)(Rb * pitch + Cc[i] * 2); }
    const size_t kstep = (size_t)(BK * 2);
    const size_t hstep = (size_t)HALF * pitch;
    const unsigned ldsw = (unsigned)wid * 1024u;
    const int aoff = lds_byte(wr * 64 + fr, fq * 8), boff = lds_byte(wc * 32 + fr, fq * 8);
#define PG8_SA(b, h) (((b) * 2 + (h)) * HTB)
#define PG8_SB(b, h) ((4 + (b) * 2 + (h)) * HTB)
#define PG8_GLDS(gptr, bufoff, i) __builtin_amdgcn_global_load_lds((const unsigned*)(gptr), (LAS unsigned*)(lds + (bufoff) + ldsw + (i) * 8192), 16, 0, 0)
#define PG8_STAGE_B(bufoff, gbase) do { _Pragma("unroll") for (int _i = 0; _i < 2; ++_i) PG8_GLDS((const char*)(gbase) + voffB[_i], bufoff, _i); } while (0)
#define PG8_STAGE_A(bufoff, TP, AO, h, koff) do { _Pragma("unroll") for (int _i = 0; _i < 2; ++_i) { \
        if constexpr (Sched::GATHER) PG8_GLDS(S.a_base() + (size_t)(koff) + AO[h][_i], bufoff, _i); \
        else PG8_GLDS((TP) + (size_t)(koff) + ((h) ? hstep : (size_t)0) + voffA[_i], bufoff, _i); } } while (0)
#define PG8_LDA(dst, b, h) do { _Pragma("unroll") for (int m = 0; m < 4; ++m) _Pragma("unroll") for (int k = 0; k < 2; ++k) dst[m][k] = *(const LAS bf16x8*)(lds + PG8_SA(b, h) + aoff + m * 2048 + k * 1024); } while (0)
#define PG8_LDB(dst, b, h) do { _Pragma("unroll") for (int n = 0; n < 2; ++n) _Pragma("unroll") for (int k = 0; k < 2; ++k) dst[n][k] = *(const LAS bf16x8*)(lds + PG8_SB(b, h) + boff + n * 2048 + k * 1024); } while (0)
#define PG8_CAT(x) __builtin_shufflevector(__builtin_bit_cast(i32x4, (x)[0]), __builtin_bit_cast(i32x4, (x)[1]), 0, 1, 2, 3, 4, 5, 6, 7)
#define PG8_MMA(ai, bj, At, Bt) do { __builtin_amdgcn_s_setprio(1); _Pragma("unroll") for (int m = 0; m < 4; ++m) _Pragma("unroll") for (int n = 0; n < 2; ++n) { \
        if constexpr (FP8) { const i32x8 _b = PG8_CAT(Bt[n]), _a = PG8_CAT(At[m]);   \
            asm volatile("v_mfma_scale_f32_16x16x128_f8f6f4 %0, %1, %2, %0, %3, %3 op_sel_hi:[0,0,0]" : "+v"(acc[ai][bj][m][n]) : "v"(_b), "v"(_a), "v"(0x7F7F7F7F)); } \
        else if constexpr (I8) { _Pragma("unroll") for (int k = 0; k < 2; ++k) acc[ai][bj][m][n] = __builtin_bit_cast(f32x4, __builtin_amdgcn_mfma_i32_16x16x64_i8(__builtin_bit_cast(i32x4, Bt[n][k]), __builtin_bit_cast(i32x4, At[m][k]), __builtin_bit_cast(i32x4, acc[ai][bj][m][n]), 0, 0, 0)); } \
        else { _Pragma("unroll") for (int k = 0; k < 2; ++k) acc[ai][bj][m][n] = __builtin_amdgcn_mfma_f32_16x16x32_bf16(Bt[n][k], At[m][k], acc[ai][bj][m][n], 0, 0, 0); } } __builtin_amdgcn_s_setprio(0); } while (0)
#define PG8_WAIT_V(n) asm volatile("s_waitcnt vmcnt(" #n ")" ::: "memory")
#define PG8_WAIT_L(n) asm volatile("s_waitcnt lgkmcnt(" #n ")" ::: "memory")
#define PG8_BAR __builtin_amdgcn_s_barrier()
#define PG8_SCHED __builtin_amdgcn_sched_barrier(0)
    Unit cur, nxt; int ui = 0;
    if (!S.next(0, cur)) return;
    f32x4 acc[2][2][4][2];
#pragma unroll
    for (int a = 0; a < 2; ++a)
#pragma unroll
        for (int b = 0; b < 2; ++b)
#pragma unroll
            for (int m = 0; m < 4; ++m)
#pragma unroll
                for (int n = 0; n < 2; ++n) acc[a][b][m][n] = (f32x4){0.f, 0.f, 0.f, 0.f};
    bf16x8 At[4][2], B0[2][2], B1[2][2];
    unsigned aoC[2][2] = {{0u, 0u}, {0u, 0u}}, aoN[2][2] = {{0u, 0u}, {0u, 0u}};
    if constexpr (Sched::GATHER) S.a_offs(0, cur, Rr, Cc, aoC);
    const char* cA = S.a_tile(cur); const char* cB = S.b_tile(cur);
    PG8_STAGE_B(PG8_SB(0, 0), cB); PG8_STAGE_B(PG8_SB(0, 1), cB + hstep); PG8_STAGE_A(PG8_SA(0, 0), cA, aoC, 0, 0); PG8_STAGE_A(PG8_SA(0, 1), cA, aoC, 1, 0);
    if (wr == 1) PG8_BAR;
    PG8_WAIT_V(2); PG8_BAR;
    PG8_STAGE_B(PG8_SB(1, 0), cB + kstep); PG8_STAGE_A(PG8_SA(1, 0), cA, aoC, 0, kstep); PG8_STAGE_B(PG8_SB(1, 1), cB + hstep + kstep);
    PG8_WAIT_V(6); PG8_BAR;
    for (;;) {
        const bool has_next = S.next(ui + 1, nxt);
        const char* nA = has_next ? S.a_tile(nxt) : cA; const char* nB = has_next ? S.b_tile(nxt) : cB;
        if constexpr (Sched::GATHER) { if (has_next) S.a_offs(ui + 1, nxt, Rr, Cc, aoN); else {
#pragma unroll
            for (int h = 0; h < 2; ++h)
#pragma unroll
                for (int i = 0; i < 2; ++i) aoN[h][i] = aoC[h][i]; } }
        constexpr int NSEG = Epi::MIDK ? 2 : 1;
#pragma unroll 1
        for (int seg = 0; seg < NSEG; ++seg) {
        if constexpr (Epi::MIDK) { if (seg == 1) { Acc& accr = acc; E.midk(accr, cur, wr, wc, fr, fq); } }
#pragma unroll 1
        for (int t = seg * (nt / NSEG); t < (seg + 1) * (nt / NSEG); t += 2) {
            const bool last = (t == nt - 2);
            const size_t k1 = (size_t)(t + 1) * kstep;
            const size_t k2 = last ? (size_t)0 : (size_t)(t + 2) * kstep, k3 = k2 + kstep;
            const char* a2 = last ? nA : cA; const char* b2 = last ? nB : cB + (size_t)(t + 2) * kstep; const char* b3 = b2 + kstep;
            unsigned ax[2][2];
#pragma unroll
            for (int h = 0; h < 2; ++h)
#pragma unroll
                for (int i = 0; i < 2; ++i) ax[h][i] = last ? aoN[h][i] : aoC[h][i];
            PG8_LDB(B0, 0, 0); PG8_LDB(B1, 0, 1); PG8_SCHED; PG8_LDA(At, 0, 0); PG8_STAGE_A(PG8_SA(1, 1), cA, aoC, 1, k1);
            PG8_WAIT_V(8); PG8_WAIT_L(0); PG8_BAR; PG8_MMA(0, 0, At, B0); PG8_MMA(0, 1, At, B1); PG8_BAR; PG8_SCHED;
            PG8_LDA(At, 0, 1); PG8_STAGE_B(PG8_SB(0, 0), b2); PG8_STAGE_B(PG8_SB(0, 1), b2 + hstep); PG8_STAGE_A(PG8_SA(0, 0), a2, ax, 0, k2);
            PG8_WAIT_V(8); PG8_WAIT_L(0); PG8_BAR; PG8_MMA(1, 0, At, B0); PG8_MMA(1, 1, At, B1); PG8_BAR; PG8_SCHED;
            PG8_LDB(B0, 1, 0); PG8_LDB(B1, 1, 1); PG8_SCHED; PG8_LDA(At, 1, 0); PG8_STAGE_A(PG8_SA(0, 1), a2, ax, 1, k2);
            PG8_WAIT_V(8); PG8_WAIT_L(0); PG8_BAR; PG8_MMA(0, 0, At, B0); PG8_MMA(0, 1, At, B1); PG8_BAR; PG8_SCHED;
            PG8_LDA(At, 1, 1); PG8_STAGE_B(PG8_SB(1, 0), b3); PG8_STAGE_B(PG8_SB(1, 1), b3 + hstep); PG8_STAGE_A(PG8_SA(1, 0), a2, ax, 0, k3);
            PG8_WAIT_V(8); PG8_WAIT_L(0); PG8_BAR; PG8_MMA(1, 0, At, B0); PG8_MMA(1, 1, At, B1); PG8_BAR; PG8_SCHED;
        }
        }
        if (wr == 0) PG8_BAR;
        E(acc, cur, ui, wr, wc, fr, fq);
        if (!has_next) break;
#pragma unroll
        for (int a = 0; a < 2; ++a)
#pragma unroll
            for (int b = 0; b < 2; ++b)
#pragma unroll
                for (int m = 0; m < 4; ++m)
#pragma unroll
                    for (int n = 0; n < 2; ++n) acc[a][b][m][n] = (f32x4){0.f, 0.f, 0.f, 0.f};
        cur = nxt; cA = nA; cB = nB; ++ui;
#pragma unroll
        for (int h = 0; h < 2; ++h)
#pragma unroll
            for (int i = 0; i < 2; ++i) aoC[h][i] = aoN[h][i];
        if (wr == 1) PG8_BAR;
    }
    PG8_WAIT_V(0);
    PG8_BAR;
#undef PG8_SA
#undef PG8_SB
#undef PG8_GLDS
#undef PG8_STAGE_A
#undef PG8_STAGE_B
#undef PG8_LDA
#undef PG8_LDB
#undef PG8_MMA
#undef PG8_CAT
#undef PG8_WAIT_V
#undef PG8_WAIT_L
#undef PG8_BAR
#undef PG8_SCHED
}
}
using pg8::Unit;

struct Params { const float* in[26]; float* out; unsigned char* ws; int ph_lo, ph_hi, li, pad; };
enum { I_X = 0, I_C, I_ADAW, I_ADAB, I_N1G, I_WIN, I_GW2, I_GGB, I_LNG, I_LNB, I_SGW, I_SGB, I_GNG, I_WA, I_WB, I_WOUT, I_N2G, I_RW, I_RB, I_EWG, I_EBG, I_EWU, I_EBU, I_EWD, I_EBD, I_FG };
#define WSP(T, off) ((T*)(p.ws + (off)))

struct DenseSched8 {
    static constexpr bool GATHER = false, FP8 = false, I8 = true;
    pg8::Order o; const char* A; const char* Bt; int K, pn0;
    __device__ __forceinline__ bool next(int i, Unit& u) const { u.e = 0; if (!o.idx(i, u.pm, u.pn)) return false; u.pn += pn0; return true; }
    __device__ __forceinline__ const char* a_base() const { return A; }
    __device__ __forceinline__ const char* a_tile(const Unit& u) const { return A + (size_t)u.pm * 256 * K; }
    __device__ __forceinline__ const char* b_tile(const Unit& u) const { return Bt + (size_t)(u.pn - pn0) * 256 * K; }
    __device__ __forceinline__ void a_offs(int, const Unit&, const int (&)[2], const int (&)[2], unsigned (&)[2][2]) const {}
};
template <bool F8> struct DenseSchedT {
    static constexpr bool GATHER = false, FP8 = F8, I8 = false; static constexpr int ES = F8 ? 1 : 2;
    pg8::Order o; const char* A; const char* Bt; int K;
    __device__ __forceinline__ bool next(int i, Unit& u) const { u.e = 0; return o.idx(i, u.pm, u.pn); }
    __device__ __forceinline__ const char* a_base() const { return A; }
    __device__ __forceinline__ const char* a_tile(const Unit& u) const { return A + (size_t)u.pm * 256 * K * ES; }
    __device__ __forceinline__ const char* b_tile(const Unit& u) const { return Bt + (size_t)u.pn * 256 * K * ES; }
    __device__ __forceinline__ void a_offs(int, const Unit&, const int (&)[2], const int (&)[2], unsigned (&)[2][2]) const {}
};
typedef DenseSchedT<false> DenseSched; typedef DenseSchedT<(MIX8 & 1) != 0> SchedM; typedef DenseSchedT<(MIX8 & 4) != 0> SchedO;
constexpr float MIXSM = (MIX8 & 1) ? W8_INV : 1.0f;
constexpr float MIXSO = (MIX8 & 4) ? W8_INV : 1.0f;
struct Moe1Sched {
    static constexpr bool GATHER = true, FP8 = true, I8 = false;
    pg8::Order o; const char* A; const char* W; const LAS int* tab; const LAS unsigned* goff;
    __device__ __forceinline__ bool next(int i, Unit& u) const { if (!o.idx(i, u.pm, u.pn)) return false; u.e = __builtin_amdgcn_readfirstlane(tab[72 + u.pm]); return true; }
    __device__ __forceinline__ const char* a_base() const { return A; }
    __device__ __forceinline__ const char* a_tile(const Unit&) const { return A; }
    __device__ __forceinline__ const char* b_tile(const Unit& u) const { return W + ((size_t)u.e * 4096 + (size_t)u.pn * 256) * 2048; }
    __device__ __forceinline__ void a_offs(int i, const Unit&, const int (&R)[2], const int (&C)[2], unsigned (&ao)[2][2]) const {
#pragma unroll
        for (int h = 0; h < 2; ++h)
#pragma unroll
            for (int j = 0; j < 2; ++j) ao[h][j] = goff[i * 256 + h * 128 + R[j]] + (unsigned)C[j] * 2u;
    }
};
struct Moe2Sched {
    static constexpr bool GATHER = false, FP8 = true, I8 = false;
    pg8::Order o; const char* A; const char* W; const LAS int* tab;
    __device__ __forceinline__ bool next(int i, Unit& u) const { if (!o.idx(i, u.pm, u.pn)) return false; u.e = __builtin_amdgcn_readfirstlane(tab[72 + u.pm]); return true; }
    __device__ __forceinline__ const char* a_base() const { return A; }
    __device__ __forceinline__ const char* a_tile(const Unit& u) const { return A + (size_t)u.pm * 256 * 2048; }
    __device__ __forceinline__ const char* b_tile(const Unit& u) const { return W + ((size_t)u.e * 2048 + (size_t)u.pn * 256) * 2048; }
    __device__ __forceinline__ void a_offs(int, const Unit&, const int (&)[2], const int (&)[2], unsigned (&)[2][2]) const {}
};

__device__ __forceinline__ u32x4 pack8(const f32x4 v0, const f32x4 v1) { u32x4 w; w.x = cvt_pk_bf16(v0[0], v0[1]); w.y = cvt_pk_bf16(v0[2], v0[3]); w.z = cvt_pk_bf16(v1[0], v1[1]); w.w = cvt_pk_bf16(v1[2], v1[3]); return w; }
template <int ACT> __device__ __forceinline__ float act_f(float x) {
    if (ACT == 1) return gelu_tanh(x);
    if (ACT == 2) return x * fast_sigmoid(x);
    if (ACT == 3) return fast_sigmoid(x);
    return x;
}
struct EpiProj {
    static constexpr bool PERM = true, MIDK = false;
    unsigned char* ws; bool i8;
    __device__ __forceinline__ void operator()(const Acc& acc, const Unit& u, int, int wr, int wc, int fr, int fq) const {
        const int pn = u.pn, row0 = u.pm * 256 + wr * 64 + fr, cw = wc * 32 + 8 * fq;
        int act, ldc = 2048, pl; size_t boff;
        if (pn < 8)       { act = 1; boff = WS_AU; pl = pn; }
        else if (pn < 16) { act = 1; boff = WS_AV; pl = pn - 8; }
        else if (pn < 20) { act = 0; boff = WS_Q; pl = pn - 16; ldc = 1024; }
        else if (pn < 24) { act = 0; boff = WS_K; pl = pn - 20; ldc = 1024; }
        else if (pn < 32) { act = 0; boff = WS_V; pl = pn - 24; }
        else if (pn < 40) { act = 2; boff = WS_R; pl = pn - 32; }
        else if (pn < 48) { act = 3; boff = WS_GA; pl = pn - 40; }
        else              { act = 3; boff = WS_GB; pl = pn - 48; }
        const bool lns = (pn >= 8 && pn < 16);
        bf16_t* base = (bf16_t*)(ws + boff); const int col0 = pl * 256 + cw;
        float* lnp = (float*)(ws + WS_LNP) + (pl * 4 + wc) * 2;
        f32x4 wsc[2][2];
#pragma unroll
        for (int bj = 0; bj < 2; ++bj) { const float* wp = (const float*)(ws + WS_WS) + pn * 256 + bj * 128 + cw; wsc[bj][0] = i8 ? *(const f32x4*)wp : (f32x4){1.f, 1.f, 1.f, 1.f}; wsc[bj][1] = i8 ? *(const f32x4*)(wp + 4) : (f32x4){1.f, 1.f, 1.f, 1.f}; }
        if (act == 0) {
#pragma unroll
            for (int ai = 0; ai < 2; ++ai)
#pragma unroll
                for (int m = 0; m < 4; ++m) { const int row = row0 + ai * 128 + m * 16; bf16_t* rowp = base + (size_t)row * ldc + col0; const float hs = i8 ? ((const float*)(ws + WS_HS))[row] : 1.0f;
#pragma unroll
                    for (int bj = 0; bj < 2; ++bj) { f32x4 v[2] = {acc[ai][bj][m][0], acc[ai][bj][m][1]};
                        if (i8) {
#pragma unroll
                            for (int j = 0; j < 4; ++j) { v[0][j] = (float)__float_as_int(v[0][j]) * (hs * wsc[bj][0][j]); v[1][j] = (float)__float_as_int(v[1][j]) * (hs * wsc[bj][1][j]); } }
                        *(u32x4*)(rowp + bj * 128) = pack8(v[0], v[1]); }
                    asm volatile("" ::: "memory"); }
            return;
        }
#pragma unroll
        for (int ai = 0; ai < 2; ++ai)
#pragma unroll
            for (int m = 0; m < 4; ++m) { const int row = row0 + ai * 128 + m * 16; bf16_t* rowp = base + (size_t)row * ldc + col0; float s = 0.f, q = 0.f;
                const float hs = i8 ? ((const float*)(ws + WS_HS))[row] : 1.0f;
#pragma unroll
                for (int bj = 0; bj < 2; ++bj) { f32x4 v[2] = {acc[ai][bj][m][0], acc[ai][bj][m][1]};
                    if (i8) {
#pragma unroll
                        for (int j = 0; j < 4; ++j) { v[0][j] = (float)__float_as_int(v[0][j]) * (hs * wsc[bj][0][j]); v[1][j] = (float)__float_as_int(v[1][j]) * (hs * wsc[bj][1][j]); } }
#pragma unroll
                    for (int h = 0; h < 2; ++h)
#pragma unroll
                        for (int j = 0; j < 4; ++j) { const float x = v[h][j]; const float t = (act == 1) ? 1.5957691216f * (x + 0.044715f * x * x * x) : x;
                            const float sg = fast_sigmoid(t); v[h][j] = (act == 3) ? sg : x * sg; }
                    if (lns) {
#pragma unroll
                        for (int h = 0; h < 2; ++h)
#pragma unroll
                            for (int j = 0; j < 4; ++j) { s += v[h][j]; q += v[h][j] * v[h][j]; } }
                    *(u32x4*)(rowp + bj * 128) = pack8(v[0], v[1]); }
                if (lns) { s += __shfl_xor(s, 16); s += __shfl_xor(s, 32); q += __shfl_xor(q, 16); q += __shfl_xor(q, 32);
                    if ((threadIdx.x & 63) < 16) *(f32x2*)(lnp + (size_t)row * 64) = (f32x2){s, q}; }
                asm volatile("" ::: "memory"); }
    }
};
struct EpiMerge {
    static constexpr bool PERM = true, MIDK = true;
    const bf16_t* GA; const bf16_t* GB; bf16_t* O;
    __device__ __forceinline__ void midk(Acc& acc, const Unit& u, int wr, int wc, int fr, int fq) const {
        const size_t off0 = (size_t)(u.pm * 256 + wr * 64 + fr) * 2048 + u.pn * 256 + wc * 32 + 8 * fq;
        const bf16_t* pa = GA + off0; const bf16_t* pb = GB + off0;
#pragma unroll
        for (int ai = 0; ai < 2; ++ai) {
#pragma unroll
            for (int m = 0; m < 4; ++m) {
#pragma unroll
                for (int bj = 0; bj < 2; ++bj) { const u32x4 a = *(const u32x4*)(pa + bj * 128), b = *(const u32x4*)(pb + bj * 128);
                    const unsigned aw[4] = {a.x, a.y, a.z, a.w}, bw[4] = {b.x, b.y, b.z, b.w};
#pragma unroll
                    for (int j = 0; j < 4; ++j) { const float r0 = bflo(aw[j]) * __builtin_amdgcn_rcpf(fmaxf(bflo(bw[j]), 1e-30f)), r1 = bfhi(aw[j]) * __builtin_amdgcn_rcpf(fmaxf(bfhi(bw[j]), 1e-30f));
                        acc[ai][bj][m][j >> 1][2 * (j & 1)] *= r0; acc[ai][bj][m][j >> 1][2 * (j & 1) + 1] *= r1; } }
                pa += 16 * 2048; pb += 16 * 2048; asm volatile("" : "+v"(pa), "+v"(pb) :: "memory"); }
            pa += 64 * 2048; pb += 64 * 2048; asm volatile("" : "+v"(pa), "+v"(pb)); }
    }
    __device__ __forceinline__ void operator()(const Acc& acc, const Unit& u, int, int wr, int wc, int fr, int fq) const {
        const int row0 = u.pm * 256 + wr * 64 + fr, col0 = u.pn * 256 + wc * 32 + 8 * fq;
#pragma unroll
        for (int ai = 0; ai < 2; ++ai)
#pragma unroll
            for (int m = 0; m < 4; ++m) { const size_t off = (size_t)(row0 + ai * 128 + m * 16) * 2048 + col0;
#pragma unroll
                for (int bj = 0; bj < 2; ++bj) { const u32x4 g = *(const u32x4*)(GB + off + bj * 128);
                    f32x4 o0 = acc[ai][bj][m][0] * MIXSM, o1 = acc[ai][bj][m][1] * MIXSM;
                    o0[0] *= bflo(g.x); o0[1] *= bfhi(g.x); o0[2] *= bflo(g.y); o0[3] *= bfhi(g.y); o1[0] *= bflo(g.z); o1[1] *= bfhi(g.z); o1[2] *= bflo(g.w); o1[3] *= bfhi(g.w);
                    if (MIX8 & 4) { u32x2 w8; w8.x = cvt4_fp8(o0[0], o0[1], o0[2], o0[3]); w8.y = cvt4_fp8(o1[0], o1[1], o1[2], o1[3]); *(u32x2*)((unsigned char*)O + off + bj * 128) = w8; }
                    else *(u32x4*)(O + off + bj * 128) = pack8(o0, o1); } }
    }
};
struct EpiOut {
    static constexpr bool PERM = true, MIDK = false;
    const float* X; const float* MOD; float* X1;
    __device__ __forceinline__ void operator()(const Acc& acc, const Unit& u, int, int wr, int wc, int fr, int fq) const {
        const int row0 = u.pm * 256 + wr * 64 + fr, col0 = u.pn * 256 + wc * 32 + 8 * fq;
        const float* gt = MOD + (size_t)((u.pm * 256) >> 11) * 12288 + 2 * 2048 + col0;
        f32x4 g[2][2];
#pragma unroll
        for (int bj = 0; bj < 2; ++bj) { g[bj][0] = *(const f32x4*)(gt + bj * 128); g[bj][1] = *(const f32x4*)(gt + bj * 128 + 4); }
#pragma unroll
        for (int ai = 0; ai < 2; ++ai)
#pragma unroll
            for (int m = 0; m < 4; ++m) { const size_t off = (size_t)(row0 + ai * 128 + m * 16) * 2048 + col0;
#pragma unroll
                for (int bj = 0; bj < 2; ++bj) { const f32x4 x0 = *(const f32x4*)(X + off + bj * 128), x1 = *(const f32x4*)(X + off + bj * 128 + 4);
                    *(f32x4*)(X1 + off + bj * 128) = x0 + g[bj][0] * (acc[ai][bj][m][0] * MIXSO); *(f32x4*)(X1 + off + bj * 128 + 4) = x1 + g[bj][1] * (acc[ai][bj][m][1] * MIXSO); } }
    }
};
struct EpiAct {
    static constexpr bool PERM = true, MIDK = false;
    const float* bg; const float* bu; bf16_t* ACT;
    __device__ __forceinline__ void operator()(const Acc& acc, const Unit& u, int, int wr, int wc, int fr, int fq) const {
        const int row0 = u.pm * 256 + wr * 64 + fr, col0 = u.pn * 128 + wc * 32 + 8 * fq;
        const f32x4 g0 = *(const f32x4*)(bg + (size_t)u.e * 2048 + col0), g1 = *(const f32x4*)(bg + (size_t)u.e * 2048 + col0 + 4);
        const f32x4 u0 = *(const f32x4*)(bu + (size_t)u.e * 2048 + col0), u1 = *(const f32x4*)(bu + (size_t)u.e * 2048 + col0 + 4);
#pragma unroll
        for (int ai = 0; ai < 2; ++ai)
#pragma unroll
            for (int m = 0; m < 4; ++m) { f32x4 o0, o1;
#pragma unroll
                for (int j = 0; j < 4; ++j) {
                    float g = fminf(acc[ai][0][m][0][j] * W8_INV + g0[j], 7.0f), up = fminf(fmaxf(acc[ai][1][m][0][j] * W8_INV + u0[j], -7.0f), 7.0f); o0[j] = (up + 1.0f) * (g * fast_sigmoid(1.702f * g));
                    g = fminf(acc[ai][0][m][1][j] * W8_INV + g1[j], 7.0f); up = fminf(fmaxf(acc[ai][1][m][1][j] * W8_INV + u1[j], -7.0f), 7.0f); o1[j] = (up + 1.0f) * (g * fast_sigmoid(1.702f * g)); }
                u32x2 w; w.x = cvt4_fp8(o0[0], o0[1], o0[2], o0[3]); w.y = cvt4_fp8(o1[0], o1[1], o1[2], o1[3]);
                *(u32x2*)((unsigned char*)ACT + (size_t)(row0 + ai * 128 + m * 16) * 2048 + col0) = w; }
    }
};
struct EpiDown {
    static constexpr bool PERM = true, MIDK = false;
    const float* bd; bf16_t* Y; const int* LIST; const LAS int* tab;
    __device__ __forceinline__ void operator()(const Acc& acc, const Unit& u, int, int wr, int wc, int fr, int fq) const {
        const int e = u.e, rt = u.pm - tab[32 + e], cnt = tab[e];
        const int col0 = u.pn * 256 + wc * 32 + 8 * fq;
        f32x4 b[2][2];
#pragma unroll
        for (int bj = 0; bj < 2; ++bj) { b[bj][0] = *(const f32x4*)(bd + (size_t)e * 2048 + col0 + bj * 128); b[bj][1] = *(const f32x4*)(bd + (size_t)e * 2048 + col0 + bj * 128 + 4); }
        int slots[2][4];
#pragma unroll
        for (int ai = 0; ai < 2; ++ai)
#pragma unroll
            for (int m = 0; m < 4; ++m) slots[ai][m] = LIST[e * 8192 + ((rt * 256 + ai * 128 + wr * 64 + m * 16 + fr) & 8191)];
#pragma unroll
        for (int ai = 0; ai < 2; ++ai)
#pragma unroll
            for (int m = 0; m < 4; ++m) { const int pos = rt * 256 + ai * 128 + wr * 64 + m * 16 + fr;
                if (pos < cnt) { const int slot = slots[ai][m]; bf16_t* rowp = Y + (size_t)slot * 2048 + col0;
#pragma unroll
                    for (int bj = 0; bj < 2; ++bj) *(u32x4*)(rowp + bj * 128) = pack8(acc[ai][bj][m][0] * W8_INV + b[bj][0], acc[ai][bj][m][1] * W8_INV + b[bj][1]); } }
    }
};

constexpr int NWAVES = 8;
template <bool F8> __device__ __forceinline__ void p0_transpose_item(const float* W, int ld, void* WT, int k0, int n0src, int rowdst, int lane, int dpitch = 2048, int dk0 = 0, LAS unsigned char* scr = nullptr) {
    const int n = lane & 31, h = lane >> 5; const float* src = W + (size_t)(k0 + 64 * h) * ld + n0src + n;
    float v[64];
#pragma unroll
    for (int i = 0; i < 64; ++i) v[i] = __builtin_nontemporal_load(src + (size_t)i * ld);
    if constexpr (F8) {
        if (scr) {
#pragma unroll
            for (int j = 0; j < 4; ++j) { u32x4 o;
#pragma unroll
                for (int q = 0; q < 4; ++q) o[q] = cvt4_fp8(v[16 * j + 4 * q] * W8_SCALE, v[16 * j + 4 * q + 1] * W8_SCALE, v[16 * j + 4 * q + 2] * W8_SCALE, v[16 * j + 4 * q + 3] * W8_SCALE);
                *(LAS u32x4*)(scr + (n * 9 + 4 * h + j) * 16) = o; }
            LDS_WAIT(); asm volatile("" ::: "memory");
#pragma unroll
            for (int j = 0; j < 4; ++j) { const int row = (lane >> 3) + 8 * j, pc = lane & 7; const u32x4 o = *(const LAS u32x4*)(scr + (row * 9 + pc) * 16);
                __builtin_nontemporal_store(o, (u32x4*)((unsigned char*)WT + (size_t)(rowdst + row) * dpitch + dk0 + k0 + 16 * pc)); }
            LDS_WAIT(); asm volatile("" ::: "memory");
        } else { unsigned char* dst = (unsigned char*)WT + (size_t)(rowdst + n) * dpitch + dk0 + k0 + 64 * h;
#pragma unroll
        for (int j = 0; j < 4; ++j) { u32x4 o;
#pragma unroll
            for (int q = 0; q < 4; ++q) o[q] = cvt4_fp8(v[16 * j + 4 * q] * W8_SCALE, v[16 * j + 4 * q + 1] * W8_SCALE, v[16 * j + 4 * q + 2] * W8_SCALE, v[16 * j + 4 * q + 3] * W8_SCALE);
            *(u32x4*)(dst + 16 * j) = o; } }
    } else { bf16_t* dst = (bf16_t*)WT + (size_t)(rowdst + n) * dpitch + dk0 + k0 + 64 * h;
#pragma unroll
        for (int j = 0; j < 8; ++j) { u32x4 o;
#pragma unroll
            for (int q = 0; q < 4; ++q) o[q] = cvt_pk_bf16(v[8 * j + 2 * q], v[8 * j + 2 * q + 1]);
            *(u32x4*)(dst + 8 * j) = o; } }
}
__device__ __forceinline__ void p0_prologue(const Params& p, LAS unsigned char* lds) {
    const int tid = threadIdx.x, lane = tid & 63, wave = __builtin_amdgcn_readfirstlane(tid >> 6), G = gridDim.x;
    if ((int)blockIdx.x < 192) {
        LAS float* sc = (LAS float*)lds; LAS float* red = (LAS float*)(lds + 32768);
        for (int i = tid; i < 4 * 2048; i += 512) { const float c = p.in[I_C][i]; sc[i] = c / (1.0f + expf(-c)); }
        __syncthreads();
        for (int item = blockIdx.x; item < 192; item += G) {
            const int cl = tid & 15, rg = tid >> 4; const float* w = p.in[I_ADAW] + item * 64 + 4 * cl;
            f32x4 a[4];
#pragma unroll
            for (int b = 0; b < 4; ++b) a[b] = (f32x4){0.f, 0.f, 0.f, 0.f};
#pragma unroll 8
            for (int i = 0; i < 64; ++i) { const int k = rg + 32 * i; const f32x4 wv = *(const f32x4*)(w + (size_t)k * 12288);
#pragma unroll
                for (int b = 0; b < 4; ++b) a[b] += wv * sc[b * 2048 + k]; }
#pragma unroll
            for (int b = 0; b < 4; ++b) *(LAS f32x4*)(red + (rg * 4 + b) * 64 + 4 * cl) = a[b];
            __syncthreads();
            if (tid < 256) { const int b = tid >> 6, col = tid & 63; float s = 0.f;
#pragma unroll 8
                for (int r = 0; r < 32; ++r) s += red[(r * 4 + b) * 64 + col];
                WSP(float, WS_MOD)[b * 12288 + item * 64 + col] = s + p.in[I_ADAB][item * 64 + col]; }
            __syncthreads();
        }
    }
    for (int i = blockIdx.x * 512 + tid; i < 16 * 2048; i += G * 512) { const int j = i >> 11, k = i & 2047; WSP(bf16_t, WS_WG_T)[i] = (bf16_t)(cvt_pk_bf16(p.in[I_WIN][(size_t)k * INW + 10240 + j], 0.f) & 0xffffu); }
    const int gw = blockIdx.x * NWAVES + wave, NGW = G * NWAVES;
    constexpr int IT_WIN = 16 * 448, IT_SQ = 16 * 64, IT_B = 3 * IT_SQ, IT_E = 32 * 3 * IT_SQ, NITEMS = IT_WIN + IT_B + IT_E;
    for (int it0 = gw; it0 < NITEMS; it0 += NGW) {
        int r = NITEMS - 1 - it0;
        if (r < IT_WIN) { const int kb = r / 448, nb = r % 448, n0 = 32 * nb; if (n0 < PROJ8_PN0 * 256) p0_transpose_item<false>(p.in[I_WIN], INW, WSP(bf16_t, WS_WIN_T), 128 * kb, n0 + (n0 >= 10240 ? 16 : 0), n0, lane);
            else p0_transpose_item<false>(p.in[I_WIN], INW, WSP(bf16_t, WS_WIN_T), 128 * kb, n0 + (n0 >= 10240 ? 16 : 0), n0, lane);
            continue; }
        r -= IT_WIN;
        if (r < IT_B) { const int which = r / IT_SQ, q = r % IT_SQ, kb = q >> 6, nb = q & 63;
            if (which < 2) { if (MIX8 & 1) p0_transpose_item<true>(p.in[I_WA + which], 2048, WSP(unsigned char, WS_WA_T), 128 * kb, 32 * nb, 32 * nb, lane, 4096, 2048 * which); else p0_transpose_item<false>(p.in[I_WA + which], 2048, WSP(bf16_t, WS_WA_T), 128 * kb, 32 * nb, 32 * nb, lane, 4096, 2048 * which); }
            else if (MIX8 & 4) p0_transpose_item<true>(p.in[I_WOUT], 2048, WSP(unsigned char, WS_WOUT_T), 128 * kb, 32 * nb, 32 * nb, lane);
            else p0_transpose_item<false>(p.in[I_WOUT], 2048, WSP(bf16_t, WS_WOUT_T), 128 * kb, 32 * nb, 32 * nb, lane);
            continue; }
        r -= IT_B;
        { const int e = r / (3 * IT_SQ), q3 = r % (3 * IT_SQ), which = q3 / IT_SQ, q = q3 % IT_SQ, kb = q >> 6, nb = q & 63, n0 = 32 * nb;
          LAS unsigned char* scr = lds + 65536 + wave * 8192;
          if (which < 2) p0_transpose_item<true>(p.in[which == 0 ? I_EWG : I_EWU] + (size_t)e * 2048 * 2048, 2048, WSP(unsigned char, WS_WGU_T) + (size_t)e * 4096 * 2048, 128 * kb, n0, (n0 >> 7) * 256 + (n0 & 127) + which * 128, lane, 2048, 0, scr);
          else p0_transpose_item<true>(p.in[I_EWD] + (size_t)e * 2048 * 2048, 2048, WSP(unsigned char, WS_WDN_T) + (size_t)e * 2048 * 2048, 128 * kb, n0, n0, lane, 2048, 0, scr); }
    }
}
__device__ __forceinline__ void p1_norm1(const Params& p) {
    const int tid = threadIdx.x, lane = tid & 63, wave = tid >> 6, G = gridDim.x, gw = blockIdx.x * NWAVES + wave, NGW = G * NWAVES;
    const float* MOD = WSP(float, WS_MOD);
    for (int m = gw; m < NTOK; m += NGW) {
        const int b = m >> 11; const float* xr = p.in[I_X] + (size_t)m * 2048; f32x4 v[8]; float s = 0.f;
#pragma unroll
        for (int j = 0; j < 8; ++j) { v[j] = *(const f32x4*)(xr + 4 * lane + 256 * j); s += (v[j][0] * v[j][0] + v[j][1] * v[j][1]) + (v[j][2] * v[j][2] + v[j][3] * v[j][3]); }
        const float rstd = rsqrtf(wave_sum(s) * (1.0f / 2048.0f) + EPS);
        bf16_t* hr = WSP(bf16_t, WS_H) + (size_t)m * 2048; float amax = 0.f;
#pragma unroll
        for (int j = 0; j < 8; ++j) { const int c = 4 * lane + 256 * j; const f32x4 g = *(const f32x4*)(p.in[I_N1G] + c), sc = *(const f32x4*)(MOD + b * 12288 + 2048 + c), sh = *(const f32x4*)(MOD + b * 12288 + c);
            const f32x4 o = v[j] * rstd * g * (sc + 1.0f) + sh; u32x2 w; w.x = cvt_pk_bf16(o[0], o[1]); w.y = cvt_pk_bf16(o[2], o[3]); *(u32x2*)(hr + c) = w;
            v[j] = o; amax = fmaxf(fmaxf(amax, fmaxf(fabsf(o[0]), fabsf(o[1]))), fmaxf(fabsf(o[2]), fabsf(o[3]))); }
        if (PROJ8_PN0 < 56) {
#pragma unroll
            for (int o = 1; o < 64; o <<= 1) amax = fmaxf(amax, __shfl_xor(amax, o));
            const float inv = amax > 0.f ? 127.0f / amax : 0.f; if (lane == 0) WSP(float, WS_HS)[m] = amax * (1.0f / 127.0f);
#pragma unroll
            for (int j = 0; j < 8; ++j) { const int c = 4 * lane + 256 * j; const int q0 = (int)rintf(v[j][0] * inv), q1 = (int)rintf(v[j][1] * inv), q2 = (int)rintf(v[j][2] * inv), q3 = (int)rintf(v[j][3] * inv);
                *(unsigned*)(WSP(unsigned char, WS_H8) + (size_t)m * 2048 + c) = (unsigned)(q0 & 255) | ((unsigned)(q1 & 255) << 8) | ((unsigned)(q2 & 255) << 16) | ((unsigned)q3 << 24); } }
    }
    for (int n = PROJ8_PN0 * 256 + gw; n < 14336; n += NGW) {
        const u32x4* src = (const u32x4*)(WSP(bf16_t, WS_WIN_T) + (size_t)n * 2048) + lane; float v[32]; float mx = 0.f;
#pragma unroll
        for (int j = 0; j < 4; ++j) { const u32x4 r = src[64 * j]; const unsigned rw_[4] = {r.x, r.y, r.z, r.w};
#pragma unroll
            for (int q = 0; q < 4; ++q) { v[8 * j + 2 * q] = bflo(rw_[q]); v[8 * j + 2 * q + 1] = bfhi(rw_[q]); mx = fmaxf(mx, fmaxf(fabsf(v[8 * j + 2 * q]), fabsf(v[8 * j + 2 * q + 1]))); } }
#pragma unroll
        for (int o = 1; o < 64; o <<= 1) mx = fmaxf(mx, __shfl_xor(mx, o));
        const float inv = mx > 0.f ? 127.0f / mx : 0.f; if (lane == 0) WSP(float, WS_WS)[n] = mx * (1.0f / 127.0f);
        unsigned char* dst = WSP(unsigned char, WS_WIN8) + (size_t)(n - PROJ8_PN0 * 256) * 2048;
#pragma unroll
        for (int j = 0; j < 4; ++j) { unsigned o[2];
#pragma unroll
            for (int q = 0; q < 2; ++q) { const int b0 = (int)rintf(v[8 * j + 4 * q] * inv), b1 = (int)rintf(v[8 * j + 4 * q + 1] * inv), b2 = (int)rintf(v[8 * j + 4 * q + 2] * inv), b3 = (int)rintf(v[8 * j + 4 * q + 3] * inv);
                o[q] = (unsigned)(b0 & 255) | ((unsigned)(b1 & 255) << 8) | ((unsigned)(b2 & 255) << 16) | ((unsigned)b3 << 24); }
            *(u32x2*)(dst + 8 * lane + 512 * j) = (u32x2){o[0], o[1]}; } }
    for (int i = blockIdx.x * 512 + tid; i < 4 * 2048 * 32; i += G * 512) { const int b = i >> 16, k = (i >> 5) & 2047, e = i & 31;
        WSP(float, WS_RWP)[i] = p.in[I_N2G][k] * (1.0f + MOD[b * 12288 + 4 * 2048 + k]) * p.in[I_RW][k * 32 + e]; }
    if (gw < 128) { const int b = gw >> 5, e = gw & 31; float s = 0.f;
        for (int k = lane; k < 2048; k += 64) s += MOD[b * 12288 + 3 * 2048 + k] * p.in[I_RW][k * 32 + e];
        s = wave_sum(s); if (lane == 0) WSP(float, WS_BIASP)[gw] = s + p.in[I_RB][e]; }
}
__device__ __forceinline__ void sg_load_w(const Params& p, LAS unsigned char* lds, int g) {
    LAS bf16_t* wl = (LAS bf16_t*)(lds + 69632); const float* Wg = p.in[I_SGW] + (size_t)g * 128 * 128; const int tid = threadIdx.x;
#pragma unroll
    for (int i = 0; i < 4; ++i) { const int idx = tid + 512 * i, r = idx >> 4, ch = idx & 15; const f32x4 w0 = *(const f32x4*)(Wg + r * 128 + 8 * ch), w1 = *(const f32x4*)(Wg + r * 128 + 8 * ch + 4);
        *(LAS u32x4*)(wl + r * 136 + 8 * ch) = pack8(w0, w1); }
}
__device__ __forceinline__ void sg_unit(const Params& p, LAS unsigned char* lds, int unit) {
    const int tid = threadIdx.x, lane = tid & 63, w = __builtin_amdgcn_readfirstlane(tid >> 6), fr = lane & 15, fq = lane >> 4;
    const int nb = unit >> 3, g = unit & 7, row0 = nb * 128, c0 = g * 256;
    LAS float* stat = (LAS float*)lds; LAS bf16_t* vt = (LAS bf16_t*)(lds + 1024);
    LAS const bf16_t* wl = (LAS const bf16_t*)(lds + 69632);
    const bf16_t* AV = WSP(bf16_t, WS_AV); const bf16_t* AU = WSP(bf16_t, WS_AU); bf16_t* YA = WSP(bf16_t, WS_YA);
    f32x4 lp4[4]; { const float* lp = WSP(float, WS_LNP) + (size_t)(row0 + (tid >> 2)) * 64 + 16 * (tid & 3);
#pragma unroll
        for (int i = 0; i < 4; ++i) lp4[i] = *(const f32x4*)(lp + 4 * i); }
    u32x4 raw[8];
#pragma unroll
    for (int i = 0; i < 8; ++i) { const int idx = tid + 512 * i; raw[i] = *(const u32x4*)(AV + (size_t)(row0 + (idx >> 5)) * 2048 + c0 + 8 * (idx & 31)); }
    u32x2 uu[8][2];
#pragma unroll
    for (int m = 0; m < 8; ++m)
#pragma unroll
        for (int n = 0; n < 2; ++n) uu[m][n] = *(const u32x2*)(AU + (size_t)(row0 + 16 * m + fr) * 2048 + c0 + 32 * w + 16 * n + 4 * fq);
    { float s = 0.f, q = 0.f;
#pragma unroll
      for (int i = 0; i < 4; ++i) { s += lp4[i][0] + lp4[i][2]; q += lp4[i][1] + lp4[i][3]; }
      s += __shfl_xor(s, 1); q += __shfl_xor(q, 1); s += __shfl_xor(s, 2); q += __shfl_xor(q, 2);
      if ((tid & 3) == 0) { const float mu = s * (1.0f / 2048.0f), var = q * (1.0f / 2048.0f) - mu * mu; stat[2 * (tid >> 2)] = mu; stat[2 * (tid >> 2) + 1] = rsqrtf(fmaxf(var, 0.f) + EPS); } }
    __syncthreads();
#pragma unroll
    for (int i = 0; i < 8; ++i) { const int idx = tid + 512 * i, s = idx >> 5, cc = idx & 31;
        const f32x4 g0 = *(const f32x4*)(p.in[I_LNG] + c0 + 8 * cc), g1 = *(const f32x4*)(p.in[I_LNG] + c0 + 8 * cc + 4), b0 = *(const f32x4*)(p.in[I_LNB] + c0 + 8 * cc), b1 = *(const f32x4*)(p.in[I_LNB] + c0 + 8 * cc + 4);
        const float mu = stat[2 * s], rs = stat[2 * s + 1]; const u32x4 r = raw[i];
        u32x2 o0, o1;
        o0.x = cvt_pk_bf16((bflo(r.x) - mu) * rs * g0[0] + b0[0], (bfhi(r.x) - mu) * rs * g0[1] + b0[1]); o0.y = cvt_pk_bf16((bflo(r.y) - mu) * rs * g0[2] + b0[2], (bfhi(r.y) - mu) * rs * g0[3] + b0[3]);
        o1.x = cvt_pk_bf16((bflo(r.z) - mu) * rs * g1[0] + b1[0], (bfhi(r.z) - mu) * rs * g1[1] + b1[1]); o1.y = cvt_pk_bf16((bflo(r.w) - mu) * rs * g1[2] + b1[2], (bfhi(r.w) - mu) * rs * g1[3] + b1[3]);
        *(LAS u32x2*)(vt + s * 260 + 8 * cc) = o0; *(LAS u32x2*)(vt + s * 260 + 8 * cc + 4) = o1; }
    __syncthreads();
    f32x4 acc[8][2];
#pragma unroll
    for (int m = 0; m < 8; ++m) { acc[m][0] = (f32x4){0.f, 0.f, 0.f, 0.f}; acc[m][1] = (f32x4){0.f, 0.f, 0.f, 0.f}; }
#pragma unroll
    for (int ks = 0; ks < 4; ++ks) {
        bf16x8 bfr[2];
#pragma unroll
        for (int n = 0; n < 2; ++n) bfr[n] = tr_frag(vt, 260, 32 * ks, 32 * w + 16 * n, fr, fq);
#pragma unroll
        for (int m = 0; m < 8; ++m) {
            if (m < 4 && ks >= 2) continue;
            const bf16x8 afr = *(const LAS bf16x8*)(wl + (16 * m + fr) * 136 + 32 * ks + 8 * fq);
#pragma unroll
            for (int n = 0; n < 2; ++n) acc[m][n] = __builtin_amdgcn_mfma_f32_16x16x32_bf16(bfr[n], afr, acc[m][n], 0, 0, 0);
        }
    }
#pragma unroll
    for (int m = 0; m < 8; ++m) { const float bs = p.in[I_SGB][g * 128 + 16 * m + fr];
#pragma unroll
        for (int n = 0; n < 2; ++n) { const size_t offy = (size_t)(row0 + 16 * m + fr) * 4096 + c0 + 32 * w + 16 * n + 4 * fq; const u32x2 u = uu[m][n];
            u32x2 o; o.x = cvt_pk_bf16(bflo(u.x) * (acc[m][n][0] + bs), bfhi(u.x) * (acc[m][n][1] + bs)); o.y = cvt_pk_bf16(bflo(u.y) * (acc[m][n][2] + bs), bfhi(u.y) * (acc[m][n][3] + bs));
            if (MIX8 & 1) *(unsigned*)((unsigned char*)YA + offy) = cvt4_fp8(bflo(u.x) * (acc[m][n][0] + bs), bfhi(u.x) * (acc[m][n][1] + bs), bflo(u.y) * (acc[m][n][2] + bs), bfhi(u.y) * (acc[m][n][3] + bs));
            else *(u32x2*)(YA + offy) = o; } }
    __syncthreads();
}
__device__ __forceinline__ void prep_unit(const Params& p, LAS unsigned char* lds, int unit) {
    const int tid = threadIdx.x, lane = tid & 63, w = __builtin_amdgcn_readfirstlane(tid >> 6), fr = lane & 15, fq = lane >> 4;
    const int h = unit & 3, r0 = (unit >> 2) * 64;
    LAS float* part = (LAS float*)lds; LAS float* glr = (LAS float*)(lds + 32768); LAS float* tot = (LAS float*)(lds + 36864); LAS float* bl = (LAS float*)(lds + 37888);
    LAS bf16_t* qd = (LAS bf16_t*)(lds + 40960); LAS bf16_t* ki = (LAS bf16_t*)(lds + 40960 + 33792);
    const bf16_t* H = WSP(bf16_t, WS_H); const bf16_t* WG = WSP(bf16_t, WS_WG_T);
    { const bf16_t* Q = WSP(bf16_t, WS_Q); const bf16_t* Kk = WSP(bf16_t, WS_K);
#pragma unroll
      for (int i = 0; i < 4; ++i) { const int idx = tid + 512 * i, row = idx >> 5, ch = idx & 31; const size_t go = (size_t)(r0 + row) * 1024 + h * 256 + 8 * ch;
          const u32x4 qv = *(const u32x4*)(Q + go), kv = *(const u32x4*)(Kk + go); *(LAS u32x4*)(qd + row * 264 + 8 * ch) = qv; *(LAS u32x4*)(ki + row * 264 + 8 * ch) = kv; } }
    { f32x4 ga[4];
#pragma unroll
      for (int m = 0; m < 4; ++m) ga[m] = (f32x4){0.f, 0.f, 0.f, 0.f};
#pragma unroll 2
      for (int ks = 0; ks < 8; ++ks) { const int kk = 256 * w + 32 * ks + 8 * fq; const bf16x8 bfr = *(const bf16x8*)(WG + fr * 2048 + kk);
#pragma unroll
          for (int m = 0; m < 4; ++m) { const bf16x8 afr = *(const bf16x8*)(H + (size_t)(r0 + 16 * m + fr) * 2048 + kk); ga[m] = __builtin_amdgcn_mfma_f32_16x16x32_bf16(afr, bfr, ga[m], 0, 0, 0); } }
#pragma unroll
      for (int m = 0; m < 4; ++m)
#pragma unroll
          for (int r = 0; r < 4; ++r) part[(w * 64 + 16 * m + 4 * fq + r) * 16 + fr] = ga[m][r]; }
    __syncthreads();
    for (int idx = tid; idx < 1024; idx += 512) { float s = 0.f;
#pragma unroll
        for (int ww = 0; ww < 8; ++ww) s += part[ww * 1024 + idx];
        glr[idx] = s; }
    __syncthreads();
    const int kc = tid & 255, half = tid >> 8, kg = h * 256 + kc;
    float cs[32];
    { float w2[16];
#pragma unroll
      for (int j = 0; j < 16; ++j) w2[j] = p.in[I_GW2][j * 1024 + kg];
      const float gb = p.in[I_GGB][kg]; float run = 0.f;
#pragma unroll
      for (int i = 0; i < 32; ++i) { const int t = 32 * half + i; const LAS f32x4* g4 = (const LAS f32x4*)(glr + t * 16); float z = gb;
#pragma unroll
          for (int j = 0; j < 4; ++j) { const f32x4 gv = g4[j]; z += gv[0] * w2[4 * j] + gv[1] * w2[4 * j + 1] + gv[2] * w2[4 * j + 2] + gv[3] * w2[4 * j + 3]; }
          const float ls = fminf(z, 0.f) - __logf(1.0f + __expf(-fabsf(z))); run += ls * 0.0625f; cs[i] = run; }
      if (half == 0) tot[kc] = run;
      __syncthreads();
      const float off = half ? tot[kc] : 0.f;
      if (half == 1) bl[kc] = off + run;
#pragma unroll
      for (int i = 0; i < 32; ++i) cs[i] += off; }
    __syncthreads();
    const float blast = bl[kc];
    { unsigned kst[16];
#pragma unroll
      for (int i = 0; i < 32; i += 2) { float ksv[2];
#pragma unroll
          for (int ii = 0; ii < 2; ++ii) { const int t = 32 * half + i + ii; const float b = cs[i + ii];
              const float q = bf2f(qd[t * 264 + kc]), k = bf2f(ki[t * 264 + kc]); const float eb = __expf(b);
              const float qdv = q * 0.0625f * eb, kiv = k * __builtin_amdgcn_rcpf(eb); ksv[ii] = k * __expf(blast - b);
              qd[t * 264 + kc] = (bf16_t)(cvt_pk_bf16(qdv, 0.f) & 0xffffu); ki[t * 264 + kc] = (bf16_t)(cvt_pk_bf16(kiv, 0.f) & 0xffffu); }
          kst[i >> 1] = cvt_pk_bf16(ksv[0], ksv[1]); }
      u32x4* kd = (u32x4*)(WSP(bf16_t, WS_KST) + ((size_t)unit * 256 + kc) * 64 + 32 * half);
#pragma unroll
      for (int j = 0; j < 4; ++j) kd[j] = (u32x4){kst[4 * j], kst[4 * j + 1], kst[4 * j + 2], kst[4 * j + 3]};
      if (half == 0) WSP(float, WS_DC)[unit * 256 + kc] = __expf(blast); }
    __syncthreads();
    { bf16_t* QD = WSP(bf16_t, WS_QD);
#pragma unroll
      for (int i = 0; i < 4; ++i) { const int idx = tid + 512 * i, row = idx >> 5, ch = idx & 31; *(u32x4*)(QD + (size_t)(r0 + row) * 1024 + h * 256 + 8 * ch) = *(const LAS u32x4*)(qd + row * 264 + 8 * ch); } }
    { const int m = w >> 1, n0 = 2 * (w & 1); f32x4 aa[2] = {(f32x4){0.f, 0.f, 0.f, 0.f}, (f32x4){0.f, 0.f, 0.f, 0.f}};
#pragma unroll
      for (int ks = 0; ks < 8; ++ks) { const bf16x8 afr = *(const LAS bf16x8*)(qd + (16 * m + fr) * 264 + 32 * ks + 8 * fq);
#pragma unroll
          for (int nn = 0; nn < 2; ++nn) { const bf16x8 bfr = *(const LAS bf16x8*)(ki + (16 * (n0 + nn) + fr) * 264 + 32 * ks + 8 * fq);
              aa[nn] = __builtin_amdgcn_mfma_f32_16x16x32_bf16(bfr, afr, aa[nn], 0, 0, 0); } }
      bf16_t* ATT = WSP(bf16_t, WS_ATT);
#pragma unroll
      for (int nn = 0; nn < 2; ++nn) { const int t = 16 * m + fr, s0 = 16 * (n0 + nn) + 4 * fq; float v[4];
#pragma unroll
          for (int r = 0; r < 4; ++r) v[r] = (s0 + r <= t) ? aa[nn][r] : 0.f;
          u32x2 o; o.x = cvt_pk_bf16(v[0], v[1]); o.y = cvt_pk_bf16(v[2], v[3]); *(u32x2*)(ATT + ((size_t)unit * 64 + t) * 64 + s0) = o; } }
    __syncthreads();
}
struct ScanSet { u32x4 qraw[4]; u32x4 kraw[4]; u32x4 araw; u32x4 vraw; float dc; };
__device__ __forceinline__ void scan_load(ScanSet& F, const Params& p, int b, int h, int c, int vc0, int tid) {
    const int u = (b * 32 + c) * 4 + h, r0 = b * 2048 + c * 64;
    const bf16_t* QD = WSP(bf16_t, WS_QD) + (size_t)r0 * 1024 + h * 256; const bf16_t* KST = WSP(bf16_t, WS_KST) + (size_t)u * 256 * 64;
#pragma unroll
    for (int i = 0; i < 4; ++i) { const int idx = tid + 512 * i; F.qraw[i] = *(const u32x4*)(QD + (size_t)(idx >> 5) * 1024 + 8 * (idx & 31)); F.kraw[i] = *(const u32x4*)(KST + (size_t)idx * 8); }
    F.araw = *(const u32x4*)(WSP(bf16_t, WS_ATT) + ((size_t)u * 64 + (tid >> 3)) * 64 + 8 * (tid & 7));
    F.vraw = *(const u32x4*)(WSP(bf16_t, WS_V) + (size_t)(r0 + (tid >> 3)) * 2048 + vc0 + 8 * (tid & 7));
    F.dc = WSP(float, WS_DC)[u * 256 + (tid & 255)];
}
__device__ __forceinline__ void scan_step(ScanSet& cur, int cnext, f32x4 (&sS)[2][4], const Params& p, LAS unsigned char* lds, int b, int h, int c, int vc0, int w, int fr, int fq, int tid) {
    LAS bf16_t* st = (LAS bf16_t*)lds;
    LAS bf16_t* vt = (LAS bf16_t*)(lds + 33792);
    LAS bf16_t* qd = (LAS bf16_t*)(lds + 43008);
    LAS bf16_t* at = (LAS bf16_t*)(lds + 76800);
    LAS bf16_t* kt = (LAS bf16_t*)(lds + 86016);
    LAS float* dcs = (LAS float*)(lds + 122880);
    const int rt = w >> 1, cp = w & 1;
#pragma unroll
    for (int i = 0; i < 2; ++i)
#pragma unroll
        for (int n = 0; n < 4; ++n) { u32x2 o; o.x = cvt_pk_bf16(sS[i][n][0], sS[i][n][1]); o.y = cvt_pk_bf16(sS[i][n][2], sS[i][n][3]);
            *(LAS u32x2*)(st + (16 * n + fr) * 264 + 32 * w + 16 * i + 4 * fq) = o; }
    *(LAS u32x4*)(vt + (tid >> 3) * 72 + 8 * (tid & 7)) = cur.vraw;
#pragma unroll
    for (int i = 0; i < 4; ++i) { const int idx = tid + 512 * i; *(LAS u32x4*)(qd + (idx >> 5) * 264 + 8 * (idx & 31)) = cur.qraw[i]; *(LAS u32x4*)(kt + (idx >> 3) * 72 + 8 * (idx & 7)) = cur.kraw[i]; }
    *(LAS u32x4*)(at + (tid >> 3) * 72 + 8 * (tid & 7)) = cur.araw;
    if (tid < 256) dcs[tid] = cur.dc;
    scan_load(cur, p, b, h, cnext, vc0, tid);
    __syncthreads();
    bf16_t* O = WSP(bf16_t, WS_O);
    bf16x8 afr[2];
#pragma unroll
    for (int ks = 0; ks < 2; ++ks) afr[ks] = *(const LAS bf16x8*)(at + (16 * rt + fr) * 72 + 32 * ks + 8 * fq);
    f32x4 dcv[2]; dcv[0] = *(const LAS f32x4*)(dcs + 32 * w + 4 * fq); dcv[1] = *(const LAS f32x4*)(dcs + 32 * w + 16 + 4 * fq);
    bf16x8 kf[2][2];
#pragma unroll
    for (int i = 0; i < 2; ++i)
#pragma unroll
        for (int ks = 0; ks < 2; ++ks) kf[i][ks] = *(const LAS bf16x8*)(kt + (32 * w + 16 * i + fr) * 72 + 32 * ks + 8 * fq);
#pragma unroll
    for (int n = 0; n < 4; ++n) { bf16x8 vf[2];
#pragma unroll
        for (int ks = 0; ks < 2; ++ks) vf[ks] = tr_frag(vt, 72, 32 * ks, 16 * n, fr, fq);
        if ((n >> 1) == cp) { const int ct = n;
            f32x4 ao = (f32x4){0.f, 0.f, 0.f, 0.f};
#pragma unroll
            for (int ks = 0; ks < 8; ++ks) { const bf16x8 sfr = *(const LAS bf16x8*)(st + (16 * ct + fr) * 264 + 32 * ks + 8 * fq), qfr = *(const LAS bf16x8*)(qd + (16 * rt + fr) * 264 + 32 * ks + 8 * fq); ao = __builtin_amdgcn_mfma_f32_16x16x32_bf16(sfr, qfr, ao, 0, 0, 0); }
#pragma unroll
            for (int ks = 0; ks < 2; ++ks) ao = __builtin_amdgcn_mfma_f32_16x16x32_bf16(vf[ks], afr[ks], ao, 0, 0, 0);
            u32x2 o; o.x = cvt_pk_bf16(ao[0], ao[1]); o.y = cvt_pk_bf16(ao[2], ao[3]);
            *(u32x2*)(O + (size_t)(b * 2048 + c * 64 + 16 * rt + fr) * 2048 + vc0 + 16 * ct + 4 * fq) = o; }
#pragma unroll
        for (int i = 0; i < 2; ++i) { sS[i][n] = sS[i][n] * dcv[i];
#pragma unroll
            for (int ks = 0; ks < 2; ++ks) sS[i][n] = __builtin_amdgcn_mfma_f32_16x16x32_bf16(kf[i][ks], vf[ks], sS[i][n], 0, 0, 0); } }
    __syncthreads();
}
__device__ __forceinline__ void scan_unit(const Params& p, LAS unsigned char* lds, int unit) {
    const int tid = threadIdx.x, lane = tid & 63, w = __builtin_amdgcn_readfirstlane(tid >> 6), fr = lane & 15, fq = lane >> 4;
    const int sl = unit & 7, h = (unit >> 3) & 3, b = unit >> 5, vc0 = h * 512 + sl * 64;
    f32x4 sS[2][4];
#pragma unroll
    for (int i = 0; i < 2; ++i)
#pragma unroll
        for (int n = 0; n < 4; ++n) sS[i][n] = (f32x4){0.f, 0.f, 0.f, 0.f};
    ScanSet A, B;
    scan_load(A, p, b, h, 0, vc0, tid); scan_load(B, p, b, h, 1, vc0, tid);
#pragma unroll 1
    for (int c = 0; c < 32; c += 2) {
        scan_step(A, c + 2 < 32 ? c + 2 : 31, sS, p, lds, b, h, c, vc0, w, fr, fq, tid);
        scan_step(B, c + 3 < 32 ? c + 3 : 31, sS, p, lds, b, h, c + 1, vc0, w, fr, fq, tid);
    }
}
__device__ __forceinline__ void p5_yb(const Params& p) {
    const int tid = threadIdx.x, lane = tid & 63, wave = tid >> 6, gw = blockIdx.x * NWAVES + wave, NGW = gridDim.x * NWAVES;
    const f32x4 g0 = *(const f32x4*)(p.in[I_GNG] + 8 * lane), g1 = *(const f32x4*)(p.in[I_GNG] + 8 * lane + 4);
    for (int m = gw; m < NTOK; m += NGW) {
#pragma unroll
        for (int hh = 0; hh < 4; ++hh) { const size_t off = (size_t)m * 2048 + hh * 512 + 8 * lane;
            const u32x4 o = *(const u32x4*)(WSP(bf16_t, WS_O) + off), r = *(const u32x4*)(WSP(bf16_t, WS_R) + off);
            float v[8] = {bflo(o.x), bfhi(o.x), bflo(o.y), bfhi(o.y), bflo(o.z), bfhi(o.z), bflo(o.w), bfhi(o.w)};
            float s = 0.f;
#pragma unroll
            for (int j = 0; j < 8; ++j) s += v[j] * v[j];
            const float rstd = rsqrtf(wave_sum(s) * (1.0f / 512.0f) + EPS);
            const float rr[8] = {bflo(r.x), bfhi(r.x), bflo(r.y), bfhi(r.y), bflo(r.z), bfhi(r.z), bflo(r.w), bfhi(r.w)};
            f32x4 y0, y1;
#pragma unroll
            for (int j = 0; j < 4; ++j) { y0[j] = v[j] * rstd * g0[j] * rr[j]; y1[j] = v[4 + j] * rstd * g1[j] * rr[4 + j]; }
            if (MIX8 & 1) { u32x2 w8; w8.x = cvt4_fp8(y0[0], y0[1], y0[2], y0[3]); w8.y = cvt4_fp8(y1[0], y1[1], y1[2], y1[3]); *(u32x2*)(WSP(unsigned char, WS_YA) + (size_t)m * 4096 + 2048 + hh * 512 + 8 * lane) = w8; }
            else *(u32x4*)(WSP(bf16_t, WS_YA) + (size_t)m * 4096 + 2048 + hh * 512 + 8 * lane) = pack8(y0, y1); }
    }
}
__device__ __forceinline__ void router_item(const Params& p, LAS unsigned char* lds, int item) {
    const int tid = threadIdx.x, lane = tid & 63, w = __builtin_amdgcn_readfirstlane(tid >> 6);
    const int R0 = item * 32, b = R0 >> 11;
    LAS float* pl = (LAS float*)lds; LAS float* sq = (LAS float*)(lds + 32768); LAS float* lg = (LAS float*)(lds + 33792); LAS float* rs = (LAS float*)(lds + 38400);
    LAS int* lcnt = (LAS int*)(lds + 38656); LAS int* lbase = (LAS int*)(lds + 38912);
    if (tid < 32) lcnt[tid] = 0;
    const float* X1 = WSP(float, WS_X1);
    { f32x16 acc;
#pragma unroll
      for (int i = 0; i < 16; ++i) acc[i] = 0.f;
      float ssq = 0.f; const int row = lane & 31, hi = lane >> 5;
      const float* xr = X1 + (size_t)(R0 + row) * 2048 + 256 * w + 4 * hi;
      const float* br = WSP(float, WS_RWP) + (size_t)b * 65536 + (size_t)(256 * w + 4 * hi) * 32 + row;
#pragma unroll 4
      for (int kb = 0; kb < 256; kb += 8) { const f32x4 va = *(const f32x4*)(xr + kb); ssq += (va[0] * va[0] + va[1] * va[1]) + (va[2] * va[2] + va[3] * va[3]);
#pragma unroll
          for (int j = 0; j < 4; ++j) acc = __builtin_amdgcn_mfma_f32_32x32x2f32(va[j], br[(kb + j) * 32], acc, 0, 0, 0); }
      ssq += __shfl_xor(ssq, 32);
      if (lane < 32) sq[w * 32 + lane] = ssq;
#pragma unroll
      for (int r = 0; r < 16; ++r) pl[(w * 32 + (r & 3) + 8 * (r >> 2) + 4 * hi) * 32 + row] = acc[r]; }
    __syncthreads();
#pragma unroll
    for (int q = 0; q < 2; ++q) { const int idx = tid + 512 * q, r = idx >> 5, e = idx & 31; float s = 0.f, ss = 0.f;
#pragma unroll
        for (int ww = 0; ww < 8; ++ww) { s += pl[ww * 1024 + idx]; ss += sq[ww * 32 + r]; }
        const float rstd = rsqrtf(ss * (1.0f / 2048.0f) + EPS); lg[r * 33 + e] = s * rstd + WSP(float, WS_BIASP)[b * 32 + e]; if (e == 0) rs[r] = rstd; }
    __syncthreads();
    int ek[4] = {0, 0, 0, 0}, rk[4] = {0, 0, 0, 0}; float wk[4] = {0.f, 0.f, 0.f, 0.f};
    if (tid < 32) { unsigned taken = 0u; float lv[4];
#pragma unroll
        for (int k = 0; k < 4; ++k) { float best = -3.0e38f; int bi = 0;
            for (int e = 0; e < 32; ++e) { const float x = lg[tid * 33 + e]; if (!((taken >> e) & 1u) && x > best) { best = x; bi = e; } }
            taken |= 1u << bi; ek[k] = bi; lv[k] = best; }
        float sum = 0.f;
#pragma unroll
        for (int k = 0; k < 4; ++k) { wk[k] = expf(lv[k] - lv[0]); sum += wk[k]; }
#pragma unroll
        for (int k = 0; k < 4; ++k) { wk[k] /= sum; rk[k] = __hip_atomic_fetch_add(&lcnt[ek[k]], 1, __ATOMIC_RELAXED, __HIP_MEMORY_SCOPE_WORKGROUP); } }
    __syncthreads();
    if (tid < 32) { const int c = lcnt[tid]; lbase[tid] = c ? (int)__hip_atomic_fetch_add((unsigned*)WSP(unsigned, WS_CTL) + CW_CNT + tid, (unsigned)c, __ATOMIC_RELAXED, __HIP_MEMORY_SCOPE_AGENT) : 0; }
    __syncthreads();
    if (tid < 32) {
#pragma unroll
        for (int k = 0; k < 4; ++k) { const int pos = lbase[ek[k]] + rk[k], slot = (R0 + tid) * 4 + k; WSP(int, WS_LIST)[ek[k] * 8192 + pos] = slot; WSP(float, WS_TOPW)[slot] = wk[k]; } }
    const float* MOD = WSP(float, WS_MOD) + b * 12288;
#pragma unroll
    for (int rr = 0; rr < 4; ++rr) { const int r = 4 * w + rr; const float rstd = rs[r]; const size_t ro = (size_t)(R0 + r) * 2048;
#pragma unroll
        for (int j = 0; j < 4; ++j) { const int c = 8 * lane + 512 * j; f32x4 o[2];
#pragma unroll
            for (int q = 0; q < 2; ++q) { const f32x4 x = *(const f32x4*)(X1 + ro + c + 4 * q), g = *(const f32x4*)(p.in[I_N2G] + c + 4 * q), sc = *(const f32x4*)(MOD + 4 * 2048 + c + 4 * q), sh = *(const f32x4*)(MOD + 3 * 2048 + c + 4 * q);
                o[q] = x * rstd * g * (sc + 1.0f) + sh; }
            u32x2 w8; w8.x = cvt4_fp8(o[0][0], o[0][1], o[0][2], o[0][3]); w8.y = cvt4_fp8(o[1][0], o[1][1], o[1][2], o[1][3]); *(u32x2*)(WSP(unsigned char, WS_H) + ro + c) = w8; } }
    __syncthreads();
}
__device__ __forceinline__ int moe_tables(const Params& p, LAS int* tab) {
    const int tid = threadIdx.x;
    if (tid < 32) tab[tid] = (int)__hip_atomic_load((unsigned*)WSP(unsigned, WS_CTL) + CW_CNT + tid, __ATOMIC_RELAXED, __HIP_MEMORY_SCOPE_AGENT);
    __syncthreads();
    if (tid == 0) { int a = 0; for (int e = 0; e < 32; ++e) { tab[32 + e] = a; const int n = (tab[e] + 255) >> 8; for (int j = 0; j < n; ++j) tab[72 + a + j] = e; a += n; } tab[64] = a; }
    __syncthreads();
    return tab[64];
}
__device__ __forceinline__ void p11_final(const Params& p) {
    const int tid = threadIdx.x, lane = tid & 63, wave = tid >> 6, gw = blockIdx.x * NWAVES + wave, NGW = gridDim.x * NWAVES;
    const float* X1 = WSP(float, WS_X1); const bf16_t* Y = WSP(bf16_t, WS_Y); const float* TW = WSP(float, WS_TOPW);
    for (int m = gw; m < NTOK; m += NGW) {
        const int b = m >> 11; const float* gt2 = WSP(float, WS_MOD) + b * 12288 + 5 * 2048;
        const f32x4 wk = *(const f32x4*)(TW + 4 * m);
        f32x4 x2[4][2]; float s = 0.f;
#pragma unroll
        for (int j = 0; j < 4; ++j) { const int c = 8 * lane + 512 * j; f32x4 mo[2] = {(f32x4){0.f, 0.f, 0.f, 0.f}, (f32x4){0.f, 0.f, 0.f, 0.f}};
#pragma unroll
            for (int k = 0; k < 4; ++k) { const u32x4 y = *(const u32x4*)(Y + ((size_t)m * 4 + k) * 2048 + c); const float wv = wk[k];
                mo[0][0] += wv * bflo(y.x); mo[0][1] += wv * bfhi(y.x); mo[0][2] += wv * bflo(y.y); mo[0][3] += wv * bfhi(y.y);
                mo[1][0] += wv * bflo(y.z); mo[1][1] += wv * bfhi(y.z); mo[1][2] += wv * bflo(y.w); mo[1][3] += wv * bfhi(y.w); }
#pragma unroll
            for (int q = 0; q < 2; ++q) { const f32x4 x = *(const f32x4*)((DBG_MODE == 1 ? p.in[I_X] : X1) + (size_t)m * 2048 + c + 4 * q), g = *(const f32x4*)(gt2 + c + 4 * q); const f32x4 v = (DBG_MODE == 0) ? x + g * mo[q] : x; x2[j][q] = v;
                s += (v[0] * v[0] + v[1] * v[1]) + (v[2] * v[2] + v[3] * v[3]); } }
        const float rstd = rsqrtf(wave_sum(s) * (1.0f / 2048.0f) + EPS);
#pragma unroll
        for (int j = 0; j < 4; ++j)
#pragma unroll
            for (int q = 0; q < 2; ++q) { const int c = 8 * lane + 512 * j + 4 * q; *(f32x4*)(p.out + (size_t)m * 2048 + c) = x2[j][q] * rstd * *(const f32x4*)(p.in[I_FG] + c); }
    }
}


__device__ __forceinline__ void dbg_out(const Params& p, int mode) {
    const size_t n = (size_t)NTOK * 2048;
    for (size_t i = (size_t)blockIdx.x * 512 + threadIdx.x; i < n; i += (size_t)gridDim.x * 512) {
        const size_t m = i >> 11, c = i & 2047; float v = 0.f;
        if (mode == 3) v = bf2f(WSP(bf16_t, WS_H)[i]) + WSP(float, WS_MOD)[i % 49152] + WSP(float, WS_RWP)[i % 262144] + bf2f(WSP(bf16_t, WS_WIN_T)[i]) + bf2f(WSP(bf16_t, WS_WA_T)[i % 4194304]) + bf2f(WSP(bf16_t, WS_WG_T)[i % 32768]);
        if (mode == 4) v = bf2f(WSP(bf16_t, WS_AU)[i]) + bf2f(WSP(bf16_t, WS_AV)[i]) + bf2f(WSP(bf16_t, WS_V)[i]) + bf2f(WSP(bf16_t, WS_R)[i]) + bf2f(WSP(bf16_t, WS_GA)[i]) + bf2f(WSP(bf16_t, WS_GB)[i]) + bf2f(WSP(bf16_t, WS_Q)[m * 1024 + (c & 1023)]) + bf2f(WSP(bf16_t, WS_K)[m * 1024 + (c & 1023)]) + WSP(float, WS_LNP)[i % 524288];
        if (mode == 5) v = bf2f(WSP(bf16_t, WS_YA)[i]);
        if (mode == 6) v = bf2f(WSP(bf16_t, WS_QD)[i % 8388608]) + bf2f(WSP(bf16_t, WS_KST)[i % 8388608]) + bf2f(WSP(bf16_t, WS_ATT)[i % 2097152]) + WSP(float, WS_DC)[i % 131072];
        if (mode == 7) v = bf2f(WSP(bf16_t, WS_O)[i]);
        if (mode == 8) v = bf2f(WSP(bf16_t, WS_YB)[i]) + WSP(float, WS_M1)[i];
        if (mode == 9) v = bf2f(WSP(bf16_t, WS_MERGED)[i]);
        p.out[i] = v;
    }
}

constexpr int PER_PHASE = 12;
constexpr int N_LAUNCHES = MK_N_LAUNCHES;
__global__ void __launch_bounds__(NWAVES * 64, 2) fwd_kernel(Params p) {
    extern __shared__ __attribute__((aligned(16))) unsigned char lds_raw[];
    LAS unsigned char* lds = (LAS unsigned char*)lds_raw;
    const int tid = threadIdx.x, G = gridDim.x;
    for (int u = tid; u < (TAB_OFF - LDSCTL_OFF) / 4; u += NWAVES * 64) ((LAS unsigned*)(lds + LDSCTL_OFF))[u] = 0u;
    __syncthreads();
    unsigned* ctl = WSP(unsigned, WS_CTL);
    XcdBarrier bar; bar.bar = ctl + CW_BAR; bar.x = 0; bar.st = nullptr;
    if (N_LAUNCHES == 1) bar = xcd_barrier_post(ctl + CW_BAR, (volatile LAS unsigned*)(lds + MISC_OFF) + 8);
    const int lo = p.ph_lo, hi = p.ph_hi;
#define IN(k) (lo <= (k) && (k) < hi)
#define SEAM(k) do { if (IN(k) && IN((k) + 1)) xcd_barrier(bar); } while (0)

    if (IN(0)) { p0_prologue(p, lds); }
    SEAM(0);
    if (IN(1)) { p1_norm1(p); }
    SEAM(1);
    if (IN(2)) {
        if (PROJ8_PN0 > 0) { DenseSched S; S.o.init(NTOK / 256, PROJ8_PN0, G, blockIdx.x); S.A = (const char*)WSP(bf16_t, WS_H); S.Bt = (const char*)WSP(bf16_t, WS_WIN_T); S.K = 2048;
            EpiProj E{p.ws, false}; pg8::gemm_phase<EpiProj, DenseSched>(lds, S, E, 2048); }
        if (PROJ8_PN0 < 56) { DenseSched8 S; S.o.init(NTOK / 256, 56 - PROJ8_PN0, G, blockIdx.x); S.A = (const char*)WSP(unsigned char, WS_H8); S.Bt = (const char*)WSP(unsigned char, WS_WIN8); S.K = 2048; S.pn0 = PROJ8_PN0;
            EpiProj E{p.ws, true}; pg8::gemm_phase<EpiProj, DenseSched8>(lds, S, E, 2048); }
    }
    SEAM(2);
    if (IN(3)) {
        if (G == 256) { const int x = blockIdx.x & 7, sidx = blockIdx.x >> 3;
            for (int i = 0; i < 2; ++i) { const int j = sidx * 2 + i; prep_unit(p, lds, ((((x >> 1) * 32 + (j >> 1)) << 2) | (2 * (x & 1) + (j & 1)))); } }
        else for (int u = blockIdx.x; u < 512; u += G) prep_unit(p, lds, u);
    }
    SEAM(3);
    if (IN(4)) {
        const int half = G >> 1, x = blockIdx.x & 7, sidx = blockIdx.x >> 3;
        if (G == 256) {
            if (!(sidx & 1)) { const int s16 = sidx >> 1; for (int r_ = 0; r_ < REP_SCAN; ++r_) scan_unit(p, lds, ((x * 2 + (s16 >> 3)) << 3) | (s16 & 7)); }
            else { const int j = (sidx >> 1) * 8 + x; sg_load_w(p, lds, j & 7); for (int r_ = 0; r_ < REP_SG; ++r_) for (int u = j; u < 512; u += half) sg_unit(p, lds, u); }
        } else { for (int u = blockIdx.x; u < 128; u += G) scan_unit(p, lds, u); for (int u = blockIdx.x; u < 512; u += G) { __syncthreads(); sg_load_w(p, lds, u & 7); sg_unit(p, lds, u); } }
    }
    SEAM(4);
    if (IN(5)) { p5_yb(p); }
    SEAM(5);
    if (IN(6)) {
        SchedM S; S.o.init(NTOK / 256, 8, G, blockIdx.x); S.A = (const char*)WSP(bf16_t, WS_YA); S.Bt = (const char*)WSP(bf16_t, WS_WA_T); S.K = 4096;
        EpiMerge E{WSP(bf16_t, WS_GA), WSP(bf16_t, WS_GB), WSP(bf16_t, WS_MERGED)};
        pg8::gemm_phase<EpiMerge, SchedM>(lds, S, E, 4096);
    }
    SEAM(6);
    if (IN(7)) {
        SchedO S; S.o.init(NTOK / 256, 8, G, blockIdx.x); S.A = (const char*)WSP(bf16_t, WS_MERGED); S.Bt = (const char*)WSP(bf16_t, WS_WOUT_T); S.K = 2048;
        EpiOut E{p.in[I_X], WSP(float, WS_MOD), WSP(float, WS_X1)};
        pg8::gemm_phase<EpiOut, SchedO>(lds, S, E, 2048);
    }
    SEAM(7);
    if (IN(8)) { for (int it = blockIdx.x; it < NTOK / 32; it += G) router_item(p, lds, it); }
    SEAM(8);
    if (IN(9)) {
        LAS int* tab = (LAS int*)(lds + TAB_OFF); LAS unsigned* goff = (LAS unsigned*)(lds + TAB_OFF + 1024);
        const int NT = moe_tables(p, tab);
        Moe1Sched S; S.o.init(NT, 16, G, blockIdx.x); S.A = (const char*)WSP(bf16_t, WS_H); S.W = (const char*)WSP(bf16_t, WS_WGU_T); S.tab = tab; S.goff = goff;
        for (int i = 0; i < 10; ++i) { int pm, pn; if (!S.o.idx(i, pm, pn)) break; const int e = tab[72 + pm], rt = pm - tab[32 + e], cnt = tab[e];
            for (int r = tid; r < 256; r += NWAVES * 64) { const int pos = rt * 256 + r; const int tok = pos < cnt ? (WSP(int, WS_LIST)[e * 8192 + pos] >> 2) : 0; goff[i * 256 + r] = (unsigned)tok * 2048u; } }
        __syncthreads();
        EpiAct E{p.in[I_EBG], p.in[I_EBU], WSP(bf16_t, WS_ACT)};
        pg8::gemm_phase<EpiAct, Moe1Sched>(lds, S, E, 2048);
    }
    SEAM(9);
    if (IN(10)) {
        LAS int* tab = (LAS int*)(lds + TAB_OFF);
        const int NT = moe_tables(p, tab);
        Moe2Sched S; S.o.init(NT, 8, G, blockIdx.x); S.A = (const char*)WSP(bf16_t, WS_ACT); S.W = (const char*)WSP(bf16_t, WS_WDN_T); S.tab = tab;
        EpiDown E{p.in[I_EBD], WSP(bf16_t, WS_Y), WSP(int, WS_LIST), tab};
        pg8::gemm_phase<EpiDown, Moe2Sched>(lds, S, E, 2048);
    }
    SEAM(10);
    if (IN(11)) { if (DBG_MODE >= 3) dbg_out(p, DBG_MODE); else p11_final(p); }
#undef IN
#undef SEAM
}

extern "C" void kernel_launch(void* const* d_in, const int* in_sizes, int n_in, void* d_out, int out_size, void* d_ws, size_t ws_size, hipStream_t stream) {
    static int grid = 0;
    if (grid == 0) {
        if (n_in != 26 || out_size != NTOK * DM || ws_size < WS_END) { fprintf(stderr, "kernel_launch: unexpected shapes (n_in %d, out %d, ws %zu); nothing launched\n", n_in, out_size, ws_size); grid = -1; return; }
        int dev = 0, cus = 0, per_cu = 0;
        if (hipGetDevice(&dev) != hipSuccess || hipDeviceGetAttribute(&cus, hipDeviceAttributeMultiprocessorCount, dev) != hipSuccess) { grid = -1; return; }
        if (hipFuncSetAttribute((const void*)fwd_kernel, hipFuncAttributeMaxDynamicSharedMemorySize, LDS_BYTES) != hipSuccess) { fprintf(stderr, "kernel_launch: hipFuncSetAttribute failed\n"); grid = -1; return; }
        if (hipOccupancyMaxActiveBlocksPerMultiprocessor(&per_cu, (const void*)fwd_kernel, NWAVES * 64, LDS_BYTES) != hipSuccess || per_cu < 1) { fprintf(stderr, "kernel_launch: occupancy query says %d blocks per CU\n", per_cu); }
        (void)hipGetLastError();
        grid = cus;
    }
    if (grid < 0) return;
    if (hipMemsetAsync((char*)d_ws + WS_CTL, 0, CTL_ZERO_BYTES, stream) != hipSuccess) return;
    Params a{};
    for (int i = 0; i < 26; ++i) a.in[i] = (const float*)d_in[i];
    a.out = (float*)d_out; a.ws = (unsigned char*)d_ws;
    for (int li = 0; li < N_LAUNCHES; ++li) {
        if (DBG_MODE == 1 && li != 11) continue;
        if (DBG_MODE == 2 && li >= 8 && li != 11) continue;
        { const int lastph[10] = {11, 11, 7, 1, 2, 3, 3, 4, 5, 6}; if (DBG_MODE >= 3 && li > lastph[DBG_MODE] && li != 11) continue; }
        a.ph_lo = (N_LAUNCHES == 1) ? 0 : li; a.ph_hi = (N_LAUNCHES == 1) ? PER_PHASE : li + 1; a.li = li; a.pad = 0;
        for (int rep_ = 0; rep_ <= ((REPEAT_MASK >> li) & 1); ++rep_) {
            if (rep_ && li == 8) (void)hipMemsetAsync((char*)d_ws + WS_CTL + CW_CNT * 4, 0, 128, stream);
        hipLaunchKernelGGL(fwd_kernel, dim3(grid), dim3(NWAVES * 64), LDS_BYTES, stream, a);
        }
        const hipError_t le = hipPeekAtLastError();
        if (le != hipSuccess) { fprintf(stderr, "kernel_launch: launch %d failed: %s\n", li, hipGetErrorName(le)); break; }
    }
}
```

```cpp
#include <hip/hip_runtime.h>
#include <cstdio>
#include <cstdint>

#ifndef DBG_MODE
#define DBG_MODE 0
#endif
#ifndef REPEAT_MASK
#define REPEAT_MASK 0
#endif
#ifndef REP_SCAN
#define REP_SCAN 1
#endif
#ifndef REP_SG
#define REP_SG 1
#endif
#ifndef PROJ8_PN0
#define PROJ8_PN0 0
#endif
#ifndef MIX8
#define MIX8 1
#endif
#ifndef MK_N_LAUNCHES
#define MK_N_LAUNCHES 1
#endif

#define LAS __attribute__((address_space(3)))
#define GAS __attribute__((address_space(1)))
typedef unsigned short bf16_t;
typedef short bf16x8 __attribute__((ext_vector_type(8)));
typedef float f32x4 __attribute__((ext_vector_type(4)));
typedef float f32x2 __attribute__((ext_vector_type(2)));
typedef float f32x16 __attribute__((ext_vector_type(16)));
typedef unsigned u32x4 __attribute__((ext_vector_type(4)));
typedef unsigned u32x2 __attribute__((ext_vector_type(2)));
typedef int i32x4 __attribute__((ext_vector_type(4)));
typedef int i32x8 __attribute__((ext_vector_type(8)));
typedef GAS unsigned gu32;
#define RLX_AGENT __ATOMIC_RELAXED, __HIP_MEMORY_SCOPE_AGENT

constexpr int DM = 2048, NB = 4, SEQ = 2048, NTOK = NB * SEQ;
constexpr int NPROJ = 14336;
constexpr int INW = 14352;
constexpr int NEXP = 32, TOPK = 4, NSLOT = NTOK * TOPK;
constexpr int MAXTILE = 160;
constexpr float EPS = 1e-6f;

constexpr size_t MiB = 1u << 20;
constexpr size_t WS_CTL = 0, CTL_ZERO_BYTES = 128 * 1024;
constexpr size_t WS_MOD = 2 * MiB;
constexpr size_t WS_RWP = 3 * MiB;
constexpr size_t WS_BIASP = 4 * MiB;
constexpr size_t WS_WG_T = 4 * MiB + 4096;
constexpr size_t WS_LNP = 5 * MiB;
constexpr size_t WS_DC = 7 * MiB;
constexpr size_t WS_TOPW = 8 * MiB;
constexpr size_t WS_LIST = 9 * MiB;
constexpr size_t WS_WIN_T = 16 * MiB;
constexpr size_t WS_WA_T = 72 * MiB, WS_WB_T = 80 * MiB, WS_WOUT_T = 88 * MiB;
constexpr size_t WS_WGU_T = 96 * MiB;
constexpr size_t WS_WDN_T = 608 * MiB;
constexpr size_t WS_H = 864 * MiB;
constexpr size_t WS_AU = 896 * MiB, WS_AV = 928 * MiB, WS_Q = 960 * MiB, WS_K = 976 * MiB, WS_V = 992 * MiB, WS_R = 1024 * MiB, WS_GA = 1056 * MiB, WS_GB = 1088 * MiB;
constexpr size_t WS_QD = 1120 * MiB, WS_KST = 1136 * MiB, WS_ATT = 1152 * MiB;
constexpr size_t WS_O = 1160 * MiB, WS_YA = 1192 * MiB, WS_YB = 1224 * MiB, WS_MERGED = 1256 * MiB, WS_X1 = 1288 * MiB, WS_M1 = 1352 * MiB;
constexpr size_t WS_H8 = WS_M1;
constexpr size_t WS_WIN8 = WS_M1 + 16 * MiB;
constexpr size_t WS_HS = 10 * MiB;
constexpr size_t WS_WS = 10 * MiB + 65536;
constexpr int CW_CMAX = 16384;
constexpr size_t WS_ACT = 1416 * MiB;
constexpr size_t WS_Y = 1576 * MiB;
constexpr size_t WS_END = 1704 * MiB;
constexpr int CW_TMO = 0, CW_CODE = 1, CW_CNT = 64, CW_BAR = 4096;

constexpr int RING_BYTES = 131072;
constexpr int LDSCTL_OFF = RING_BYTES, MISC_OFF = LDSCTL_OFF + 320;
constexpr int TAB_OFF = RING_BYTES + 1024;
constexpr int LDS_BYTES = 147456;

typedef __bf16 bf16x2_t __attribute__((ext_vector_type(2)));
__device__ __forceinline__ unsigned cvt_pk_bf16(float lo, float hi) { const f32x2 v = {lo, hi}; const bf16x2_t b = __builtin_convertvector(v, bf16x2_t); unsigned r; __builtin_memcpy(&r, &b, 4); return r; }
__device__ __forceinline__ float bf2f(unsigned short b) { return __uint_as_float(((unsigned)b) << 16); }
__device__ __forceinline__ float bflo(unsigned w) { return __uint_as_float(w << 16); }
__device__ __forceinline__ float bfhi(unsigned w) { return __uint_as_float(w & 0xffff0000u); }
__device__ __forceinline__ float fast_sigmoid(float x) { return __builtin_amdgcn_rcpf(1.0f + __expf(-x)); }
__device__ __forceinline__ float gelu_tanh(float x) { const float u = 0.7978845608f * (x + 0.044715f * x * x * x); return x * fast_sigmoid(2.0f * u); }
__device__ __forceinline__ float wave_sum(float v) {
#pragma unroll
    for (int o = 1; o < 64; o <<= 1) v += __shfl_xor(v, o);
    return v;
}

typedef short s16x4 __attribute__((ext_vector_type(4)));
__device__ __forceinline__ bf16x8 tr_frag(const LAS bf16_t* tile, int pitch, int row0, int col0, int fr, int fq) {
    const LAS bf16_t* a = tile + (row0 + 8 * fq + (fr >> 2)) * pitch + col0 + 4 * (fr & 3);
    const s16x4 lo = __builtin_amdgcn_ds_read_tr16_b64_v4i16((LAS s16x4*)a), hi = __builtin_amdgcn_ds_read_tr16_b64_v4i16((LAS s16x4*)(a + 4 * pitch));
    return (bf16x8){lo[0], lo[1], lo[2], lo[3], hi[0], hi[1], hi[2], hi[3]};
}

__device__ __forceinline__ unsigned cvt4_fp8(float a, float b, float c, float d) { int w = __builtin_amdgcn_cvt_pk_fp8_f32(a, b, 0, false); w = __builtin_amdgcn_cvt_pk_fp8_f32(c, d, w, true); return (unsigned)w; }
constexpr float W8_SCALE = 64.0f, W8_INV = 1.0f / 64.0f;
#define LDS_WAIT() asm volatile("s_waitcnt lgkmcnt(0)" ::: "memory")
#define VM_WAIT() asm volatile("s_waitcnt vmcnt(0)" ::: "memory")

#define XB_TMO      128
#define XB_XCNT(j)  (256  + 64 * (j))
#define XB_XSUB(j)  (1280 + 64 * (j))
#define XB_XGEN(j)  (2304 + 64 * (j))
#define XB_TOP      3328
#define XB_TOPGEN   3392
#define XCD_BAR_WORDS 3456
#define XB_SPIN_CAP (1u << 18)
__device__ __forceinline__ unsigned xb_ld(unsigned* p)              { return __hip_atomic_load(p, __ATOMIC_RELAXED, __HIP_MEMORY_SCOPE_AGENT); }
__device__ __forceinline__ unsigned xb_add(unsigned* p, unsigned v) { return __hip_atomic_fetch_add(p, v, __ATOMIC_RELAXED, __HIP_MEMORY_SCOPE_AGENT); }
__device__ __forceinline__ unsigned xb_xcc_id() { return (unsigned)__builtin_amdgcn_s_getreg((3 << 11) | 20) & 0xFu; }
#define XB_SPIN(cond, bar) do { unsigned _sp = 0; while (cond) { __builtin_amdgcn_s_sleep(1); \
    if ((++_sp & 255u) == 0u) { if (xb_ld(&(bar)[XB_TMO])) break; if (_sp > XB_SPIN_CAP) { atomicAdd(&(bar)[XB_TMO], 1u); break; } } } } while (0)
struct XcdBarrier { unsigned* bar; unsigned x; volatile LAS unsigned* st; };
__device__ __forceinline__ XcdBarrier xcd_barrier_post(unsigned* bar, volatile LAS unsigned* st) {
    XcdBarrier b; b.bar = bar; b.x = xb_xcc_id(); b.st = st;
    if (threadIdx.x == 0) (void)xb_add(&bar[XB_XCNT(b.x)], 1u);
    return b;
}
__device__ __forceinline__ void xcd_barrier_complete(unsigned* bar, unsigned x, unsigned& nloc, unsigned& nx) {
    const unsigned G = gridDim.x * gridDim.y * gridDim.z;
    unsigned sum, cnt, mine, sp = 0u;
    for (;;) {
        sum = 0u; cnt = 0u; mine = 0u;
#pragma unroll
        for (unsigned j = 0; j < 16; ++j) { const unsigned c = xb_ld(&bar[XB_XCNT(j)]); sum += c; cnt += (c > 0u) ? 1u : 0u; mine = (j == x) ? c : mine; }
        if (sum == G) break;
        __builtin_amdgcn_s_sleep(1);
        if ((++sp & 255u) == 0u) { if (xb_ld(&bar[XB_TMO])) break; if (sp > XB_SPIN_CAP) { atomicAdd(&bar[XB_TMO], 1u); break; } }
    }
    nloc = mine > 0u ? mine : 1u; nx = cnt > 0u ? cnt : 1u;
}
__device__ __forceinline__ void xcd_barrier(const XcdBarrier& b) {
    asm volatile("s_waitcnt vmcnt(0)" ::: "memory");
    __syncthreads();
    if (threadIdx.x == 0) {
        unsigned* bar = b.bar;
        __builtin_amdgcn_s_waitcnt(0);
        unsigned nloc = b.st[0], nx = b.st[1];
        if (nloc == 0u) { xcd_barrier_complete(bar, b.x, nloc, nx); b.st[0] = nloc; b.st[1] = nx; }
        const unsigned old = xb_add(&bar[XB_XSUB(b.x)], 1u);
        const unsigned gen = old / nloc;
        if (old + 1u == (gen + 1u) * nloc) {
            __builtin_amdgcn_fence(__ATOMIC_RELEASE, "agent");
            asm volatile("s_waitcnt vmcnt(0)" ::: "memory");
            const unsigned og = xb_add(&bar[XB_TOP], 1u);
            const unsigned tg = og / nx;
            if (og + 1u == (tg + 1u) * nx) xb_add(&bar[XB_TOPGEN], 1u);
            else XB_SPIN(xb_ld(&bar[XB_TOPGEN]) == tg, bar);
            __builtin_amdgcn_fence(__ATOMIC_ACQUIRE, "agent");
            xb_add(&bar[XB_XGEN(b.x)], 1u);
            asm volatile("s_waitcnt vmcnt(0)" ::: "memory");
        } else {
            XB_SPIN(xb_ld(&bar[XB_XGEN(b.x)]) == gen, bar);
            __builtin_amdgcn_fence(__ATOMIC_ACQUIRE, "agent");
            asm volatile("s_waitcnt vmcnt(0)" ::: "memory");
        }
    }
    __syncthreads();
}

typedef f32x4 Acc[2][2][4][2];
namespace pg8 {
constexpr int BM = 256, BK = 64, HALF = 128, HTB = HALF * BK * 2, NXCD = 8, WGM = 8;
__host__ __device__ __forceinline__ int lds_byte(int r, int c) { const int st = (r >> 4) * 2 + (c >> 5), rr = r & 15, cc = c & 31, ob = rr * 64 + cc * 2; return st * 1024 + (ob ^ (((ob >> 9) & 1) << 5)); }
__host__ __device__ __forceinline__ void stage_rc(int b, int& R, int& C) { const int st = b / 1024, sb = b % 1024, swz = sb ^ (((sb >> 9) & 1) << 5); R = (st >> 1) * 16 + swz / 64; C = (st & 1) * 32 + (swz % 64) / 2; }
__host__ __device__ __forceinline__ int perm32(int rho) { const int n = rho >> 4, i = rho & 15; return 8 * (i >> 2) + 4 * n + (i & 3); }

struct Unit { int pm, pn, e; };
struct Order {
    int nM, nN, nwg, G, c;
    __device__ __forceinline__ void init(int nM_, int nN_, int G_, int c_) { nM = nM_; nN = nN_; nwg = nM * nN; G = G_; c = c_; }
    __device__ __forceinline__ bool idx(int i, int& pm, int& pn) const {
        const long L = (long)i * G + c; if (L >= nwg) return false;
        int wgid = (int)L; { const int q = nwg / NXCD, r = nwg % NXCD, xcd = wgid % NXCD, off = wgid / NXCD; wgid = (xcd < r ? xcd * (q + 1) : r * (q + 1) + (xcd - r) * q) + off; }
        const int nig = WGM * nN, gid = wgid / nig, fm = gid * WGM, gsz = (nM - fm) < WGM ? (nM - fm) : WGM;
        pm = fm + ((wgid % nig) % gsz); pn = (wgid % nig) / gsz; return true;
    }
};

template <class Epi, class Sched>
__device__ __forceinline__ void gemm_phase(LAS unsigned char* lds, const Sched& S, const Epi& E, const int K) {
    const int tid = threadIdx.x, wid = __builtin_amdgcn_readfirstlane(tid >> 6), lane = tid & 63, wr = wid >> 2, wc = wid & 3, fr = lane & 15, fq = lane >> 4;
    constexpr bool I8 = Sched::I8;
    constexpr bool FP8 = Sched::FP8;
    const int nt = (FP8 || I8) ? K / 128 : K / BK; const int pitch = (FP8 || I8) ? K : 2 * K;
    int Rr[2], Cc[2]; unsigned voffA[2], voffB[2];
#pragma unroll
    for (int i = 0; i < 2; ++i) { stage_rc(tid * 16 + i * 8192, Rr[i], Cc[i]); const int Rb = Epi::PERM ? ((Rr[i] & ~31) + perm32(Rr[i] & 31)) : Rr[i];
        voffA[i] = (unsigned)(Rr[i] * pitch + Cc[i] * 2); voffB[i] = (unsigned)(Rb * pitch + Cc[i] * 2); }
    const size_t kstep = (size_t)(BK * 2);
    const size_t hstep = (size_t)HALF * pitch;
    const unsigned ldsw = (unsigned)wid * 1024u;
    const int aoff = lds_byte(wr * 64 + fr, fq * 8), boff = lds_byte(wc * 32 + fr, fq * 8);
#define PG8_SA(b, h) (((b) * 2 + (h)) * HTB)
#define PG8_SB(b, h) ((4 + (b) * 2 + (h)) * HTB)
#define PG8_GLDS(gptr, bufoff, i) __builtin_amdgcn_global_load_lds((const unsigned*)(gptr), (LAS unsigned*)(lds + (bufoff) + ldsw + (i) * 8192), 16, 0, 0)
#define PG8_STAGE_B(bufoff, gbase) do { _Pragma("unroll") for (int _i = 0; _i < 2; ++_i) PG8_GLDS((const char*)(gbase) + voffB[_i], bufoff, _i); } while (0)
#define PG8_STAGE_A(bufoff, TP, AO, h, koff) do { _Pragma("unroll") for (int _i = 0; _i < 2; ++_i) { \
        if constexpr (Sched::GATHER) PG8_GLDS(S.a_base() + (size_t)(koff) + AO[h][_i], bufoff, _i); \
        else PG8_GLDS((TP) + (size_t)(koff) + ((h) ? hstep : (size_t)0) + voffA[_i], bufoff, _i); } } while (0)
#define PG8_LDA(dst, b, h) do { _Pragma("unroll") for (int m = 0; m < 4; ++m) _Pragma("unroll") for (int k = 0; k < 2; ++k) dst[m][k] = *(const LAS bf16x8*)(lds + PG8_SA(b, h) + aoff + m * 2048 + k * 1024); } while (0)
#define PG8_LDB(dst, b, h) do { _Pragma("unroll") for (int n = 0; n < 2; ++n) _Pragma("unroll") for (int k = 0; k < 2; ++k) dst[n][k] = *(const LAS bf16x8*)(lds + PG8_SB(b, h) + boff + n * 2048 + k * 1024); } while (0)
#define PG8_CAT(x) __builtin_shufflevector(__builtin_bit_cast(i32x4, (x)[0]), __builtin_bit_cast(i32x4, (x)[1]), 0, 1, 2, 3, 4, 5, 6, 7)
#define PG8_MMA(ai, bj, At, Bt) do { __builtin_amdgcn_s_setprio(1); _Pragma("unroll") for (int m = 0; m < 4; ++m) _Pragma("unroll") for (int n = 0; n < 2; ++n) { \
        if constexpr (FP8) { const i32x8 _b = PG8_CAT(Bt[n]), _a = PG8_CAT(At[m]);   \
            asm volatile("v_mfma_scale_f32_16x16x128_f8f6f4 %0, %1, %2, %0, %3, %3 op_sel_hi:[0,0,0]" : "+v"(acc[ai][bj][m][n]) : "v"(_b), "v"(_a), "v"(0x7F7F7F7F)); } \
        else if constexpr (I8) { _Pragma("unroll") for (int k = 0; k < 2; ++k) acc[ai][bj][m][n] = __builtin_bit_cast(f32x4, __builtin_amdgcn_mfma_i32_16x16x64_i8(__builtin_bit_cast(i32x4, Bt[n][k]), __builtin_bit_cast(i32x4, At[m][k]), __builtin_bit_cast(i32x4, acc[ai][bj][m][n]), 0, 0, 0)); } \
        else { _Pragma("unroll") for (int k = 0; k < 2; ++k) acc[ai][bj][m][n] = __builtin_amdgcn_mfma_f32_16x16x32_bf16(Bt[n][k], At[m][k], acc[ai][bj][m][n], 0, 0, 0); } } __builtin_amdgcn_s_setprio(0); } while (0)
#define PG8_WAIT_V(n) asm volatile("s_waitcnt vmcnt(" #n ")" ::: "memory")
#define PG8_WAIT_L(n) asm volatile("s_waitcnt lgkmcnt(" #n ")" ::: "memory")
#define PG8_BAR __builtin_amdgcn_s_barrier()
#define PG8_SCHED __builtin_amdgcn_sched_barrier(0)
    Unit cur, nxt; int ui = 0;
    if (!S.next(0, cur)) return;
    f32x4 acc[2][2][4][2];
#pragma unroll
    for (int a = 0; a < 2; ++a)
#pragma unroll
        for (int b = 0; b < 2; ++b)
#pragma unroll
            for (int m = 0; m < 4; ++m)
#pragma unroll
                for (int n = 0; n < 2; ++n) acc[a][b][m][n] = (f32x4){0.f, 0.f, 0.f, 0.f};
    bf16x8 At[4][2], B0[2][2], B1[2][2];
    unsigned aoC[2][2] = {{0u, 0u}, {0u, 0u}}, aoN[2][2] = {{0u, 0u}, {0u, 0u}};
    if constexpr (Sched::GATHER) S.a_offs(0, cur, Rr, Cc, aoC);
    const char* cA = S.a_tile(cur); const char* cB = S.b_tile(cur);
    PG8_STAGE_B(PG8_SB(0, 0), cB); PG8_STAGE_B(PG8_SB(0, 1), cB + hstep); PG8_STAGE_A(PG8_SA(0, 0), cA, aoC, 0, 0); PG8_STAGE_A(PG8_SA(0, 1), cA, aoC, 1, 0);
    if (wr == 1) PG8_BAR;
    PG8_WAIT_V(2); PG8_BAR;
    PG8_STAGE_B(PG8_SB(1, 0), cB + kstep); PG8_STAGE_A(PG8_SA(1, 0), cA, aoC, 0, kstep); PG8_STAGE_B(PG8_SB(1, 1), cB + hstep + kstep);
    PG8_WAIT_V(6); PG8_BAR;
    for (;;) {
        const bool has_next = S.next(ui + 1, nxt);
        const char* nA = has_next ? S.a_tile(nxt) : cA; const char* nB = has_next ? S.b_tile(nxt) : cB;
        if constexpr (Sched::GATHER) { if (has_next) S.a_offs(ui + 1, nxt, Rr, Cc, aoN); else {
#pragma unroll
            for (int h = 0; h < 2; ++h)
#pragma unroll
                for (int i = 0; i < 2; ++i) aoN[h][i] = aoC[h][i]; } }
        constexpr int NSEG = Epi::MIDK ? 2 : 1;
#pragma unroll 1
        for (int seg = 0; seg < NSEG; ++seg) {
        if constexpr (Epi::MIDK) { if (seg == 1) { Acc& accr = acc; E.midk(accr, cur, wr, wc, fr, fq); } }
#pragma unroll 1
        for (int t = seg * (nt / NSEG); t < (seg + 1) * (nt / NSEG); t += 2) {
            const bool last = (t == nt - 2);
            const size_t k1 = (size_t)(t + 1) * kstep;
            const size_t k2 = last ? (size_t)0 : (size_t)(t + 2) * kstep, k3 = k2 + kstep;
            const char* a2 = last ? nA : cA; const char* b2 = last ? nB : cB + (size_t)(t + 2) * kstep; const char* b3 = b2 + kstep;
            unsigned ax[2][2];
#pragma unroll
            for (int h = 0; h < 2; ++h)
#pragma unroll
                for (int i = 0; i < 2; ++i) ax[h][i] = last ? aoN[h][i] : aoC[h][i];
            PG8_LDB(B0, 0, 0); PG8_LDB(B1, 0, 1); PG8_SCHED; PG8_LDA(At, 0, 0); PG8_STAGE_A(PG8_SA(1, 1), cA, aoC, 1, k1);
            PG8_WAIT_V(8); PG8_WAIT_L(0); PG8_BAR; PG8_MMA(0, 0, At, B0); PG8_MMA(0, 1, At, B1); PG8_BAR; PG8_SCHED;
            PG8_LDA(At, 0, 1); PG8_STAGE_B(PG8_SB(0, 0), b2); PG8_STAGE_B(PG8_SB(0, 1), b2 + hstep); PG8_STAGE_A(PG8_SA(0, 0), a2, ax, 0, k2);
            PG8_WAIT_V(8); PG8_WAIT_L(0); PG8_BAR; PG8_MMA(1, 0, At, B0); PG8_MMA(1, 1, At, B1); PG8_BAR; PG8_SCHED;
            PG8_LDB(B0, 1, 0); PG8_LDB(B1, 1, 1); PG8_SCHED; PG8_LDA(At, 1, 0); PG8_STAGE_A(PG8_SA(0, 1), a2, ax, 1, k2);
            PG8_WAIT_V(8); PG8_WAIT_L(0); PG8_BAR; PG8_MMA(0, 0, At, B0); PG8_MMA(0, 1, At, B1); PG8_BAR; PG8_SCHED;
            PG8_LDA(At, 1, 1); PG8_STAGE_B(PG8_SB(1, 0), b3); PG8_STAGE_B(PG8_SB(1, 1), b3 + hstep); PG8_STAGE_A(PG8_SA(1, 0), a2, ax, 0, k3);
            PG8_WAIT_V(8); PG8_WAIT_L(0); PG8_BAR; PG8_MMA(1, 0, At, B0); PG8_MMA(1, 1, At, B1); PG8_BAR; PG8_SCHED;
        }
        }
        if (wr == 0) PG8_BAR;
        E(acc, cur, ui, wr, wc, fr, fq);
        if (!has_next) break;
#pragma unroll
        for (int a = 0; a < 2; ++a)
#pragma unroll
            for (int b = 0; b < 2; ++b)
#pragma unroll
                for (int m = 0; m < 4; ++m)
#pragma unroll
                    for (int n = 0; n < 2; ++n) acc[a][b][m][n] = (f32x4){0.f, 0.f, 0.f, 0.f};
        cur = nxt; cA = nA; cB = nB; ++ui;
#pragma unroll
        for (int h = 0; h < 2; ++h)
#pragma unroll
            for (int i = 0; i < 2; ++i) aoC[h][i] = aoN[h][i];
        if (wr == 1) PG8_BAR;
    }
    PG8_WAIT_V(0);
    PG8_BAR;
#undef PG8_SA
#undef PG8_SB
#undef PG8_GLDS
#undef PG8_STAGE_A
#undef PG8_STAGE_B
#undef PG8_LDA
#undef PG8_LDB
#undef PG8_MMA
#undef PG8_CAT
#undef PG8_WAIT_V
#undef PG8_WAIT_L
#undef PG8_BAR
#undef PG8_SCHED
}
}
using pg8::Unit;

struct Params { const float* in[26]; float* out; unsigned char* ws; int ph_lo, ph_hi, li, pad; };
enum { I_X = 0, I_C, I_ADAW, I_ADAB, I_N1G, I_WIN, I_GW2, I_GGB, I_LNG, I_LNB, I_SGW, I_SGB, I_GNG, I_WA, I_WB, I_WOUT, I_N2G, I_RW, I_RB, I_EWG, I_EBG, I_EWU, I_EBU, I_EWD, I_EBD, I_FG };
#define WSP(T, off) ((T*)(p.ws + (off)))

struct DenseSched8 {
    static constexpr bool GATHER = false, FP8 = false, I8 = true;
    pg8::Order o; const char* A; const char* Bt; int K, pn0;
    __device__ __forceinline__ bool next(int i, Unit& u) const { u.e = 0; if (!o.idx(i, u.pm, u.pn)) return false; u.pn += pn0; return true; }
    __device__ __forceinline__ const char* a_base() const { return A; }
    __device__ __forceinline__ const char* a_tile(const Unit& u) const { return A + (size_t)u.pm * 256 * K; }
    __device__ __forceinline__ const char* b_tile(const Unit& u) const { return Bt + (size_t)(u.pn - pn0) * 256 * K; }
    __device__ __forceinline__ void a_offs(int, const Unit&, const int (&)[2], const int (&)[2], unsigned (&)[2][2]) const {}
};
template <bool F8> struct DenseSchedT {
    static constexpr bool GATHER = false, FP8 = F8, I8 = false; static constexpr int ES = F8 ? 1 : 2;
    pg8::Order o; const char* A; const char* Bt; int K;
    __device__ __forceinline__ bool next(int i, Unit& u) const { u.e = 0; return o.idx(i, u.pm, u.pn); }
    __device__ __forceinline__ const char* a_base() const { return A; }
    __device__ __forceinline__ const char* a_tile(const Unit& u) const { return A + (size_t)u.pm * 256 * K * ES; }
    __device__ __forceinline__ const char* b_tile(const Unit& u) const { return Bt + (size_t)u.pn * 256 * K * ES; }
    __device__ __forceinline__ void a_offs(int, const Unit&, const int (&)[2], const int (&)[2], unsigned (&)[2][2]) const {}
};
typedef DenseSchedT<false> DenseSched; typedef DenseSchedT<(MIX8 & 1) != 0> SchedM; typedef DenseSchedT<(MIX8 & 4) != 0> SchedO;
constexpr float MIXSM = (MIX8 & 1) ? W8_INV : 1.0f;
constexpr float MIXSO = (MIX8 & 4) ? W8_INV : 1.0f;
struct Moe1Sched {
    static constexpr bool GATHER = true, FP8 = true, I8 = false;
    pg8::Order o; const char* A; const char* W; const LAS int* tab; const LAS unsigned* goff;
    __device__ __forceinline__ bool next(int i, Unit& u) const { if (!o.idx(i, u.pm, u.pn)) return false; u.e = __builtin_amdgcn_readfirstlane(tab[72 + u.pm]); return true; }
    __device__ __forceinline__ const char* a_base() const { return A; }
    __device__ __forceinline__ const char* a_tile(const Unit&) const { return A; }
    __device__ __forceinline__ const char* b_tile(const Unit& u) const { return W + ((size_t)u.e * 4096 + (size_t)u.pn * 256) * 2048; }
    __device__ __forceinline__ void a_offs(int i, const Unit&, const int (&R)[2], const int (&C)[2], unsigned (&ao)[2][2]) const {
#pragma unroll
        for (int h = 0; h < 2; ++h)
#pragma unroll
            for (int j = 0; j < 2; ++j) ao[h][j] = goff[i * 256 + h * 128 + R[j]] + (unsigned)C[j] * 2u;
    }
};
struct Moe2Sched {
    static constexpr bool GATHER = false, FP8 = true, I8 = false;
    pg8::Order o; const char* A; const char* W; const LAS int* tab;
    __device__ __forceinline__ bool next(int i, Unit& u) const { if (!o.idx(i, u.pm, u.pn)) return false; u.e = __builtin_amdgcn_readfirstlane(tab[72 + u.pm]); return true; }
    __device__ __forceinline__ const char* a_base() const { return A; }
    __device__ __forceinline__ const char* a_tile(const Unit& u) const { return A + (size_t)u.pm * 256 * 2048; }
    __device__ __forceinline__ const char* b_tile(const Unit& u) const { return W + ((size_t)u.e * 2048 + (size_t)u.pn * 256) * 2048; }
    __device__ __forceinline__ void a_offs(int, const Unit&, const int (&)[2], const int (&)[2], unsigned (&)[2][2]) const {}
};

__device__ __forceinline__ u32x4 pack8(const f32x4 v0, const f32x4 v1) { u32x4 w; w.x = cvt_pk_bf16(v0[0], v0[1]); w.y = cvt_pk_bf16(v0[2], v0[3]); w.z = cvt_pk_bf16(v1[0], v1[1]); w.w = cvt_pk_bf16(v1[2], v1[3]); return w; }
template <int ACT> __device__ __forceinline__ float act_f(float x) {
    if (ACT == 1) return gelu_tanh(x);
    if (ACT == 2) return x * fast_sigmoid(x);
    if (ACT == 3) return fast_sigmoid(x);
    return x;
}
struct EpiProj {
    static constexpr bool PERM = true, MIDK = false;
    unsigned char* ws; bool i8;
    __device__ __forceinline__ void operator()(const Acc& acc, const Unit& u, int, int wr, int wc, int fr, int fq) const {
        const int pn = u.pn, row0 = u.pm * 256 + wr * 64 + fr, cw = wc * 32 + 8 * fq;
        int act, ldc = 2048, pl; size_t boff;
        if (pn < 8)       { act = 1; boff = WS_AU; pl = pn; }
        else if (pn < 16) { act = 1; boff = WS_AV; pl = pn - 8; }
        else if (pn < 20) { act = 0; boff = WS_Q; pl = pn - 16; ldc = 1024; }
        else if (pn < 24) { act = 0; boff = WS_K; pl = pn - 20; ldc = 1024; }
        else if (pn < 32) { act = 0; boff = WS_V; pl = pn - 24; }
        else if (pn < 40) { act = 2; boff = WS_R; pl = pn - 32; }
        else if (pn < 48) { act = 3; boff = WS_GA; pl = pn - 40; }
        else              { act = 3; boff = WS_GB; pl = pn - 48; }
        const bool lns = (pn >= 8 && pn < 16);
        bf16_t* base = (bf16_t*)(ws + boff); const int col0 = pl * 256 + cw;
        float* lnp = (float*)(ws + WS_LNP) + (pl * 4 + wc) * 2;
        f32x4 wsc[2][2];
#pragma unroll
        for (int bj = 0; bj < 2; ++bj) { const float* wp = (const float*)(ws + WS_WS) + pn * 256 + bj * 128 + cw; wsc[bj][0] = i8 ? *(const f32x4*)wp : (f32x4){1.f, 1.f, 1.f, 1.f}; wsc[bj][1] = i8 ? *(const f32x4*)(wp + 4) : (f32x4){1.f, 1.f, 1.f, 1.f}; }
        if (act == 0) {
#pragma unroll
            for (int ai = 0; ai < 2; ++ai)
#pragma unroll
                for (int m = 0; m < 4; ++m) { const int row = row0 + ai * 128 + m * 16; bf16_t* rowp = base + (size_t)row * ldc + col0; const float hs = i8 ? ((const float*)(ws + WS_HS))[row] : 1.0f;
#pragma unroll
                    for (int bj = 0; bj < 2; ++bj) { f32x4 v[2] = {acc[ai][bj][m][0], acc[ai][bj][m][1]};
                        if (i8) {
#pragma unroll
                            for (int j = 0; j < 4; ++j) { v[0][j] = (float)__float_as_int(v[0][j]) * (hs * wsc[bj][0][j]); v[1][j] = (float)__float_as_int(v[1][j]) * (hs * wsc[bj][1][j]); } }
                        *(u32x4*)(rowp + bj * 128) = pack8(v[0], v[1]); }
                    asm volatile("" ::: "memory"); }
            return;
        }
#pragma unroll
        for (int ai = 0; ai < 2; ++ai)
#pragma unroll
            for (int m = 0; m < 4; ++m) { const int row = row0 + ai * 128 + m * 16; bf16_t* rowp = base + (size_t)row * ldc + col0; float s = 0.f, q = 0.f;
                const float hs = i8 ? ((const float*)(ws + WS_HS))[row] : 1.0f;
#pragma unroll
                for (int bj = 0; bj < 2; ++bj) { f32x4 v[2] = {acc[ai][bj][m][0], acc[ai][bj][m][1]};
                    if (i8) {
#pragma unroll
                        for (int j = 0; j < 4; ++j) { v[0][j] = (float)__float_as_int(v[0][j]) * (hs * wsc[bj][0][j]); v[1][j] = (float)__float_as_int(v[1][j]) * (hs * wsc[bj][1][j]); } }
#pragma unroll
                    for (int h = 0; h < 2; ++h)
#pragma unroll
                        for (int j = 0; j < 4; ++j) { const float x = v[h][j]; const float t = (act == 1) ? 1.5957691216f * (x + 0.044715f * x * x * x) : x;
                            const float sg = fast_sigmoid(t); v[h][j] = (act == 3) ? sg : x * sg; }
                    if (lns) {
#pragma unroll
                        for (int h = 0; h < 2; ++h)
#pragma unroll
                            for (int j = 0; j < 4; ++j) { s += v[h][j]; q += v[h][j] * v[h][j]; } }
                    *(u32x4*)(rowp + bj * 128) = pack8(v[0], v[1]); }
                if (lns) { s += __shfl_xor(s, 16); s += __shfl_xor(s, 32); q += __shfl_xor(q, 16); q += __shfl_xor(q, 32);
                    if ((threadIdx.x & 63) < 16) *(f32x2*)(lnp + (size_t)row * 64) = (f32x2){s, q}; }
                asm volatile("" ::: "memory"); }
    }
};
struct EpiMerge {
    static constexpr bool PERM = true, MIDK = true;
    const bf16_t* GA; const bf16_t* GB; bf16_t* O;
    __device__ __forceinline__ void midk(Acc& acc, const Unit& u, int wr, int wc, int fr, int fq) const {
        const size_t off0 = (size_t)(u.pm * 256 + wr * 64 + fr) * 2048 + u.pn * 256 + wc * 32 + 8 * fq;
        const bf16_t* pa = GA + off0; const bf16_t* pb = GB + off0;
#pragma unroll
        for (int ai = 0; ai < 2; ++ai) {
#pragma unroll
            for (int m = 0; m < 4; ++m) {
#pragma unroll
                for (int bj = 0; bj < 2; ++bj) { const u32x4 a = *(const u32x4*)(pa + bj * 128), b = *(const u32x4*)(pb + bj * 128);
                    const unsigned aw[4] = {a.x, a.y, a.z, a.w}, bw[4] = {b.x, b.y, b.z, b.w};
#pragma unroll
                    for (int j = 0; j < 4; ++j) { const float r0 = bflo(aw[j]) * __builtin_amdgcn_rcpf(fmaxf(bflo(bw[j]), 1e-30f)), r1 = bfhi(aw[j]) * __builtin_amdgcn_rcpf(fmaxf(bfhi(bw[j]), 1e-30f));
                        acc[ai][bj][m][j >> 1][2 * (j & 1)] *= r0; acc[ai][bj][m][j >> 1][2 * (j & 1) + 1] *= r1; } }
                pa += 16 * 2048; pb += 16 * 2048; asm volatile("" : "+v"(pa), "+v"(pb) :: "memory"); }
            pa += 64 * 2048; pb += 64 * 2048; asm volatile("" : "+v"(pa), "+v"(pb)); }
    }
    __device__ __forceinline__ void operator()(const Acc& acc, const Unit& u, int, int wr, int wc, int fr, int fq) const {
        const int row0 = u.pm * 256 + wr * 64 + fr, col0 = u.pn * 256 + wc * 32 + 8 * fq;
#pragma unroll
        for (int ai = 0; ai < 2; ++ai)
#pragma unroll
            for (int m = 0; m < 4; ++m) { const size_t off = (size_t)(row0 + ai * 128 + m * 16) * 2048 + col0;
#pragma unroll
                for (int bj = 0; bj < 2; ++bj) { const u32x4 g = *(const u32x4*)(GB + off + bj * 128);
                    f32x4 o0 = acc[ai][bj][m][0] * MIXSM, o1 = acc[ai][bj][m][1] * MIXSM;
                    o0[0] *= bflo(g.x); o0[1] *= bfhi(g.x); o0[2] *= bflo(g.y); o0[3] *= bfhi(g.y); o1[0] *= bflo(g.z); o1[1] *= bfhi(g.z); o1[2] *= bflo(g.w); o1[3] *= bfhi(g.w);
                    if (MIX8 & 4) { u32x2 w8; w8.x = cvt4_fp8(o0[0], o0[1], o0[2], o0[3]); w8.y = cvt4_fp8(o1[0], o1[1], o1[2], o1[3]); *(u32x2*)((unsigned char*)O + off + bj * 128) = w8; }
                    else *(u32x4*)(O + off + bj * 128) = pack8(o0, o1); } }
    }
};
struct EpiOut {
    static constexpr bool PERM = true, MIDK = false;
    const float* X; const float* MOD; float* X1;
    __device__ __forceinline__ void operator()(const Acc& acc, const Unit& u, int, int wr, int wc, int fr, int fq) const {
        const int row0 = u.pm * 256 + wr * 64 + fr, col0 = u.pn * 256 + wc * 32 + 8 * fq;
        const float* gt = MOD + (size_t)((u.pm * 256) >> 11) * 12288 + 2 * 2048 + col0;
        f32x4 g[2][2];
#pragma unroll
        for (int bj = 0; bj < 2; ++bj) { g[bj][0] = *(const f32x4*)(gt + bj * 128); g[bj][1] = *(const f32x4*)(gt + bj * 128 + 4); }
#pragma unroll
        for (int ai = 0; ai < 2; ++ai)
#pragma unroll
            for (int m = 0; m < 4; ++m) { const size_t off = (size_t)(row0 + ai * 128 + m * 16) * 2048 + col0;
#pragma unroll
                for (int bj = 0; bj < 2; ++bj) { const f32x4 x0 = *(const f32x4*)(X + off + bj * 128), x1 = *(const f32x4*)(X + off + bj * 128 + 4);
                    *(f32x4*)(X1 + off + bj * 128) = x0 + g[bj][0] * (acc[ai][bj][m][0] * MIXSO); *(f32x4*)(X1 + off + bj * 128 + 4) = x1 + g[bj][1] * (acc[ai][bj][m][1] * MIXSO); } }
    }
};
struct EpiAct {
    static constexpr bool PERM = true, MIDK = false;
    const float* bg; const float* bu; bf16_t* ACT;
    __device__ __forceinline__ void operator()(const Acc& acc, const Unit& u, int, int wr, int wc, int fr, int fq) const {
        const int row0 = u.pm * 256 + wr * 64 + fr, col0 = u.pn * 128 + wc * 32 + 8 * fq;
        const f32x4 g0 = *(const f32x4*)(bg + (size_t)u.e * 2048 + col0), g1 = *(const f32x4*)(bg + (size_t)u.e * 2048 + col0 + 4);
        const f32x4 u0 = *(const f32x4*)(bu + (size_t)u.e * 2048 + col0), u1 = *(const f32x4*)(bu + (size_t)u.e * 2048 + col0 + 4);
#pragma unroll
        for (int ai = 0; ai < 2; ++ai)
#pragma unroll
            for (int m = 0; m < 4; ++m) { f32x4 o0, o1;
#pragma unroll
                for (int j = 0; j < 4; ++j) {
                    float g = fminf(acc[ai][0][m][0][j] * W8_INV + g0[j], 7.0f), up = fminf(fmaxf(acc[ai][1][m][0][j] * W8_INV + u0[j], -7.0f), 7.0f); o0[j] = (up + 1.0f) * (g * fast_sigmoid(1.702f * g));
                    g = fminf(acc[ai][0][m][1][j] * W8_INV + g1[j], 7.0f); up = fminf(fmaxf(acc[ai][1][m][1][j] * W8_INV + u1[j], -7.0f), 7.0f); o1[j] = (up + 1.0f) * (g * fast_sigmoid(1.702f * g)); }
                u32x2 w; w.x = cvt4_fp8(o0[0], o0[1], o0[2], o0[3]); w.y = cvt4_fp8(o1[0], o1[1], o1[2], o1[3]);
                *(u32x2*)((unsigned char*)ACT + (size_t)(row0 + ai * 128 + m * 16) * 2048 + col0) = w; }
    }
};
struct EpiDown {
    static constexpr bool PERM = true, MIDK = false;
    const float* bd; bf16_t* Y; const int* LIST; const LAS int* tab;
    __device__ __forceinline__ void operator()(const Acc& acc, const Unit& u, int, int wr, int wc, int fr, int fq) const {
        const int e = u.e, rt = u.pm - tab[32 + e], cnt = tab[e];
        const int col0 = u.pn * 256 + wc * 32 + 8 * fq;
        f32x4 b[2][2];
#pragma unroll
        for (int bj = 0; bj < 2; ++bj) { b[bj][0] = *(const f32x4*)(bd + (size_t)e * 2048 + col0 + bj * 128); b[bj][1] = *(const f32x4*)(bd + (size_t)e * 2048 + col0 + bj * 128 + 4); }
        int slots[2][4];
#pragma unroll
        for (int ai = 0; ai < 2; ++ai)
#pragma unroll
            for (int m = 0; m < 4; ++m) slots[ai][m] = LIST[e * 8192 + ((rt * 256 + ai * 128 + wr * 64 + m * 16 + fr) & 8191)];
#pragma unroll
        for (int ai = 0; ai < 2; ++ai)
#pragma unroll
            for (int m = 0; m < 4; ++m) { const int pos = rt * 256 + ai * 128 + wr * 64 + m * 16 + fr;
                if (pos < cnt) { const int slot = slots[ai][m]; bf16_t* rowp = Y + (size_t)slot * 2048 + col0;
#pragma unroll
                    for (int bj = 0; bj < 2; ++bj) *(u32x4*)(rowp + bj * 128) = pack8(acc[ai][bj][m][0] * W8_INV + b[bj][0], acc[ai][bj][m][1] * W8_INV + b[bj][1]); } }
    }
};

constexpr int NWAVES = 8;
template <bool F8> __device__ __forceinline__ void p0_transpose_item(const float* W, int ld, void* WT, int k0, int n0src, int rowdst, int lane, int dpitch = 2048, int dk0 = 0, LAS unsigned char* scr = nullptr) {
    const int n = lane & 31, h = lane >> 5; const float* src = W + (size_t)(k0 + 64 * h) * ld + n0src + n;
    float v[64];
#pragma unroll
    for (int i = 0; i < 64; ++i) v[i] = __builtin_nontemporal_load(src + (size_t)i * ld);
    if constexpr (F8) {
        if (scr) {
#pragma unroll
            for (int j = 0; j < 4; ++j) { u32x4 o;
#pragma unroll
                for (int q = 0; q < 4; ++q) o[q] = cvt4_fp8(v[16 * j + 4 * q] * W8_SCALE, v[16 * j + 4 * q + 1] * W8_SCALE, v[16 * j + 4 * q + 2] * W8_SCALE, v[16 * j + 4 * q + 3] * W8_SCALE);
                *(LAS u32x4*)(scr + (n * 9 + 4 * h + j) * 16) = o; }
            LDS_WAIT(); asm volatile("" ::: "memory");
#pragma unroll
            for (int j = 0; j < 4; ++j) { const int row = (lane >> 3) + 8 * j, pc = lane & 7; const u32x4 o = *(const LAS u32x4*)(scr + (row * 9 + pc) * 16);
                __builtin_nontemporal_store(o, (u32x4*)((unsigned char*)WT + (size_t)(rowdst + row) * dpitch + dk0 + k0 + 16 * pc)); }
            LDS_WAIT(); asm volatile("" ::: "memory");
        } else { unsigned char* dst = (unsigned char*)WT + (size_t)(rowdst + n) * dpitch + dk0 + k0 + 64 * h;
#pragma unroll
        for (int j = 0; j < 4; ++j) { u32x4 o;
#pragma unroll
            for (int q = 0; q < 4; ++q) o[q] = cvt4_fp8(v[16 * j + 4 * q] * W8_SCALE, v[16 * j + 4 * q + 1] * W8_SCALE, v[16 * j + 4 * q + 2] * W8_SCALE, v[16 * j + 4 * q + 3] * W8_SCALE);
            *(u32x4*)(dst + 16 * j) = o; } }
    } else { bf16_t* dst = (bf16_t*)WT + (size_t)(rowdst + n) * dpitch + dk0 + k0 + 64 * h;
#pragma unroll
        for (int j = 0; j < 8; ++j) { u32x4 o;
#pragma unroll
            for (int q = 0; q < 4; ++q) o[q] = cvt_pk_bf16(v[8 * j + 2 * q], v[8 * j + 2 * q + 1]);
            *(u32x4*)(dst + 8 * j) = o; } }
}
constexpr int DSPLIT_E0 = 4, DSPLIT_E1 = 12, DSPLIT_ITEMS = (DSPLIT_E1 - DSPLIT_E0) * 1024;
constexpr int XSPLIT = 128 * 8 * 12;
__device__ __forceinline__ void p0_expert_item(const Params& p, LAS unsigned char* scr, int r, int lane) {
    constexpr int IT_SQ = 16 * 64;
    const int e = r / (3 * IT_SQ), q3 = r % (3 * IT_SQ), which = q3 / IT_SQ, q = q3 % IT_SQ, kb = q >> 6, nb = q & 63, n0 = 32 * nb;
    if (which < 2) p0_transpose_item<true>(p.in[which == 0 ? I_EWG : I_EWU] + (size_t)e * 2048 * 2048, 2048, WSP(unsigned char, WS_WGU_T) + (size_t)e * 4096 * 2048, 128 * kb, n0, (n0 >> 7) * 256 + (n0 & 127) + which * 128, lane, 2048, 0, scr);
    else p0_transpose_item<true>(p.in[I_EWD] + (size_t)e * 2048 * 2048, 2048, WSP(unsigned char, WS_WDN_T) + (size_t)e * 2048 * 2048, 128 * kb, n0, n0, lane, 2048, 0, scr);
}
__device__ __forceinline__ void xp_load(const Params& p, float (&v)[64], int r, int lane) {
    constexpr int IT_SQ = 16 * 64;
    const int e = r / (3 * IT_SQ), q3 = r % (3 * IT_SQ), which = q3 / IT_SQ, q = q3 % IT_SQ, kb = q >> 6, nb = q & 63;
    const float* W = p.in[which == 0 ? I_EWG : which == 1 ? I_EWU : I_EWD] + (size_t)e * 2048 * 2048;
    const int n = lane & 31, h = lane >> 5; const float* src = W + (size_t)(128 * kb + 64 * h) * 2048 + 32 * nb + n;
#pragma unroll
    for (int i = 0; i < 64; ++i) v[i] = __builtin_nontemporal_load(src + (size_t)i * 2048);
}
__device__ __forceinline__ void xp_store(const Params& p, const float (&v)[64], int r, int lane, LAS unsigned char* scr) {
    constexpr int IT_SQ = 16 * 64;
    const int e = r / (3 * IT_SQ), q3 = r % (3 * IT_SQ), which = q3 / IT_SQ, q = q3 % IT_SQ, kb = q >> 6, nb = q & 63, n0 = 32 * nb;
    unsigned char* WT = which < 2 ? WSP(unsigned char, WS_WGU_T) + (size_t)e * 4096 * 2048 : WSP(unsigned char, WS_WDN_T) + (size_t)e * 2048 * 2048;
    const int rowdst = which < 2 ? (n0 >> 7) * 256 + (n0 & 127) + which * 128 : n0, n = lane & 31, h = lane >> 5;
#pragma unroll
    for (int j = 0; j < 4; ++j) { u32x4 o;
#pragma unroll
        for (int q4 = 0; q4 < 4; ++q4) o[q4] = cvt4_fp8(v[16 * j + 4 * q4] * W8_SCALE, v[16 * j + 4 * q4 + 1] * W8_SCALE, v[16 * j + 4 * q4 + 2] * W8_SCALE, v[16 * j + 4 * q4 + 3] * W8_SCALE);
        *(LAS u32x4*)(scr + (n * 9 + 4 * h + j) * 16) = o; }
    LDS_WAIT(); asm volatile("" ::: "memory");
#pragma unroll
    for (int j = 0; j < 4; ++j) { const int row = (lane >> 3) + 8 * j, pc = lane & 7; const u32x4 o = *(const LAS u32x4*)(scr + (row * 9 + pc) * 16);
        __builtin_nontemporal_store(o, (u32x4*)(WT + (size_t)(rowdst + row) * 2048 + 128 * kb + 16 * pc)); }
    LDS_WAIT(); asm volatile("" ::: "memory");
}
template <bool DN> __device__ __forceinline__ void xp_run(const Params& p, LAS unsigned char* scr, int base, int stride, int n, int lane) {
    auto item = [&](int i) { const int x = base + stride * i; return DN ? (DSPLIT_E0 + (x >> 10)) * 3072 + 2048 + (x & 1023) : x; };
    float va[64], vb[64];
    if (n > 0) xp_load(p, va, item(0), lane);
    for (int i = 0; i < n; i += 2) {
        if (i + 1 < n) xp_load(p, vb, item(i + 1), lane);
        xp_store(p, va, item(i), lane, scr);
        if (i + 2 < n) xp_load(p, va, item(i + 2), lane);
        if (i + 1 < n) xp_store(p, vb, item(i + 1), lane, scr);
    }
}
__device__ __forceinline__ void p0_prologue(const Params& p, LAS unsigned char* lds) {
    const int tid = threadIdx.x, lane = tid & 63, wave = __builtin_amdgcn_readfirstlane(tid >> 6), G = gridDim.x;
    if ((int)blockIdx.x < 192) {
        LAS float* sc = (LAS float*)lds; LAS float* red = (LAS float*)(lds + 32768);
        for (int i = tid; i < 4 * 2048; i += 512) { const float c = p.in[I_C][i]; sc[i] = c / (1.0f + expf(-c)); }
        __syncthreads();
        for (int item = blockIdx.x; item < 192; item += G) {
            const int cl = tid & 15, rg = tid >> 4; const float* w = p.in[I_ADAW] + item * 64 + 4 * cl;
            f32x4 a[4];
#pragma unroll
            for (int b = 0; b < 4; ++b) a[b] = (f32x4){0.f, 0.f, 0.f, 0.f};
#pragma unroll 8
            for (int i = 0; i < 64; ++i) { const int k = rg + 32 * i; const f32x4 wv = *(const f32x4*)(w + (size_t)k * 12288);
#pragma unroll
                for (int b = 0; b < 4; ++b) a[b] += wv * sc[b * 2048 + k]; }
#pragma unroll
            for (int b = 0; b < 4; ++b) *(LAS f32x4*)(red + (rg * 4 + b) * 64 + 4 * cl) = a[b];
            __syncthreads();
            if (tid < 256) { const int b = tid >> 6, col = tid & 63; float s = 0.f;
#pragma unroll 8
                for (int r = 0; r < 32; ++r) s += red[(r * 4 + b) * 64 + col];
                WSP(float, WS_MOD)[b * 12288 + item * 64 + col] = s + p.in[I_ADAB][item * 64 + col]; }
            __syncthreads();
        }
    }
    for (int i = blockIdx.x * 512 + tid; i < 16 * 2048; i += G * 512) { const int j = i >> 11, k = i & 2047; WSP(bf16_t, WS_WG_T)[i] = (bf16_t)(cvt_pk_bf16(p.in[I_WIN][(size_t)k * INW + 10240 + j], 0.f) & 0xffffu); }
    const int gw = blockIdx.x * NWAVES + wave, NGW = G * NWAVES;
    constexpr int IT_WIN = 16 * 448, IT_SQ = 16 * 64, IT_B = 3 * IT_SQ, IT_E = 32 * 3 * IT_SQ, NITEMS = IT_WIN + IT_B + IT_E;
    for (int it0 = gw; it0 < NITEMS; it0 += NGW) {
        int r = NITEMS - 1 - it0;
        if (r < IT_WIN) { const int kb = r / 448, nb = r % 448, n0 = 32 * nb; if (n0 < PROJ8_PN0 * 256) p0_transpose_item<false>(p.in[I_WIN], INW, WSP(bf16_t, WS_WIN_T), 128 * kb, n0 + (n0 >= 10240 ? 16 : 0), n0, lane);
            else p0_transpose_item<false>(p.in[I_WIN], INW, WSP(bf16_t, WS_WIN_T), 128 * kb, n0 + (n0 >= 10240 ? 16 : 0), n0, lane);
            continue; }
        r -= IT_WIN;
        if (r < IT_B) { const int which = r / IT_SQ, q = r % IT_SQ, kb = q >> 6, nb = q & 63;
            if (which < 2) { if (MIX8 & 1) p0_transpose_item<true>(p.in[I_WA + which], 2048, WSP(unsigned char, WS_WA_T), 128 * kb, 32 * nb, 32 * nb, lane, 4096, 2048 * which); else p0_transpose_item<false>(p.in[I_WA + which], 2048, WSP(bf16_t, WS_WA_T), 128 * kb, 32 * nb, 32 * nb, lane, 4096, 2048 * which); }
            else if (MIX8 & 4) p0_transpose_item<true>(p.in[I_WOUT], 2048, WSP(unsigned char, WS_WOUT_T), 128 * kb, 32 * nb, 32 * nb, lane);
            else p0_transpose_item<false>(p.in[I_WOUT], 2048, WSP(bf16_t, WS_WOUT_T), 128 * kb, 32 * nb, 32 * nb, lane);
            continue; }
        r -= IT_B;
        if (G == 256 && r < XSPLIT) continue;
        if (G == 256 && (r / IT_SQ) % 3 == 2 && r / (3 * IT_SQ) >= DSPLIT_E0 && r / (3 * IT_SQ) < DSPLIT_E1) continue;
        p0_expert_item(p, lds + 65536 + wave * 8192, r, lane);
    }
}
__device__ __forceinline__ void p1_norm1(const Params& p) {
    const int tid = threadIdx.x, lane = tid & 63, wave = tid >> 6, G = gridDim.x, gw = blockIdx.x * NWAVES + wave, NGW = G * NWAVES;
    const float* MOD = WSP(float, WS_MOD);
    for (int m = gw; m < NTOK; m += NGW) {
        const int b = m >> 11; const float* xr = p.in[I_X] + (size_t)m * 2048; f32x4 v[8]; float s = 0.f;
#pragma unroll
        for (int j = 0; j < 8; ++j) { v[j] = *(const f32x4*)(xr + 4 * lane + 256 * j); s += (v[j][0] * v[j][0] + v[j][1] * v[j][1]) + (v[j][2] * v[j][2] + v[j][3] * v[j][3]); }
        const float rstd = rsqrtf(wave_sum(s) * (1.0f / 2048.0f) + EPS);
        bf16_t* hr = WSP(bf16_t, WS_H) + (size_t)m * 2048; float amax = 0.f;
#pragma unroll
        for (int j = 0; j < 8; ++j) { const int c = 4 * lane + 256 * j; const f32x4 g = *(const f32x4*)(p.in[I_N1G] + c), sc = *(const f32x4*)(MOD + b * 12288 + 2048 + c), sh = *(const f32x4*)(MOD + b * 12288 + c);
            const f32x4 o = v[j] * rstd * g * (sc + 1.0f) + sh; u32x2 w; w.x = cvt_pk_bf16(o[0], o[1]); w.y = cvt_pk_bf16(o[2], o[3]); *(u32x2*)(hr + c) = w;
            v[j] = o; amax = fmaxf(fmaxf(amax, fmaxf(fabsf(o[0]), fabsf(o[1]))), fmaxf(fabsf(o[2]), fabsf(o[3]))); }
        if (PROJ8_PN0 < 56) {
#pragma unroll
            for (int o = 1; o < 64; o <<= 1) amax = fmaxf(amax, __shfl_xor(amax, o));
            const float inv = amax > 0.f ? 127.0f / amax : 0.f; if (lane == 0) WSP(float, WS_HS)[m] = amax * (1.0f / 127.0f);
#pragma unroll
            for (int j = 0; j < 8; ++j) { const int c = 4 * lane + 256 * j; const int q0 = (int)rintf(v[j][0] * inv), q1 = (int)rintf(v[j][1] * inv), q2 = (int)rintf(v[j][2] * inv), q3 = (int)rintf(v[j][3] * inv);
                *(unsigned*)(WSP(unsigned char, WS_H8) + (size_t)m * 2048 + c) = (unsigned)(q0 & 255) | ((unsigned)(q1 & 255) << 8) | ((unsigned)(q2 & 255) << 16) | ((unsigned)q3 << 24); } }
    }
    for (int n = PROJ8_PN0 * 256 + gw; n < 14336; n += NGW) {
        const u32x4* src = (const u32x4*)(WSP(bf16_t, WS_WIN_T) + (size_t)n * 2048) + lane; float v[32]; float mx = 0.f;
#pragma unroll
        for (int j = 0; j < 4; ++j) { const u32x4 r = src[64 * j]; const unsigned rw_[4] = {r.x, r.y, r.z, r.w};
#pragma unroll
            for (int q = 0; q < 4; ++q) { v[8 * j + 2 * q] = bflo(rw_[q]); v[8 * j + 2 * q + 1] = bfhi(rw_[q]); mx = fmaxf(mx, fmaxf(fabsf(v[8 * j + 2 * q]), fabsf(v[8 * j + 2 * q + 1]))); } }
#pragma unroll
        for (int o = 1; o < 64; o <<= 1) mx = fmaxf(mx, __shfl_xor(mx, o));
        const float inv = mx > 0.f ? 127.0f / mx : 0.f; if (lane == 0) WSP(float, WS_WS)[n] = mx * (1.0f / 127.0f);
        unsigned char* dst = WSP(unsigned char, WS_WIN8) + (size_t)(n - PROJ8_PN0 * 256) * 2048;
#pragma unroll
        for (int j = 0; j < 4; ++j) { unsigned o[2];
#pragma unroll
            for (int q = 0; q < 2; ++q) { const int b0 = (int)rintf(v[8 * j + 4 * q] * inv), b1 = (int)rintf(v[8 * j + 4 * q + 1] * inv), b2 = (int)rintf(v[8 * j + 4 * q + 2] * inv), b3 = (int)rintf(v[8 * j + 4 * q + 3] * inv);
                o[q] = (unsigned)(b0 & 255) | ((unsigned)(b1 & 255) << 8) | ((unsigned)(b2 & 255) << 16) | ((unsigned)b3 << 24); }
            *(u32x2*)(dst + 8 * lane + 512 * j) = (u32x2){o[0], o[1]}; } }
    for (int i = blockIdx.x * 512 + tid; i < 4 * 2048 * 32; i += G * 512) { const int b = i >> 16, k = (i >> 5) & 2047, e = i & 31;
        WSP(float, WS_RWP)[i] = p.in[I_N2G][k] * (1.0f + MOD[b * 12288 + 4 * 2048 + k]) * p.in[I_RW][k * 32 + e]; }
    if (gw < 128) { const int b = gw >> 5, e = gw & 31; float s = 0.f;
        for (int k = lane; k < 2048; k += 64) s += MOD[b * 12288 + 3 * 2048 + k] * p.in[I_RW][k * 32 + e];
        s = wave_sum(s); if (lane == 0) WSP(float, WS_BIASP)[gw] = s + p.in[I_RB][e]; }
}
__device__ __forceinline__ void sg_load_w(const Params& p, LAS unsigned char* lds, int g) {
    LAS bf16_t* wl = (LAS bf16_t*)(lds + 69632); const float* Wg = p.in[I_SGW] + (size_t)g * 128 * 128; const int tid = threadIdx.x;
#pragma unroll
    for (int i = 0; i < 4; ++i) { const int idx = tid + 512 * i, r = idx >> 4, ch = idx & 15; const f32x4 w0 = *(const f32x4*)(Wg + r * 128 + 8 * ch), w1 = *(const f32x4*)(Wg + r * 128 + 8 * ch + 4);
        *(LAS u32x4*)(wl + r * 136 + 8 * ch) = pack8(w0, w1); }
}
__device__ __forceinline__ void sg_unit(const Params& p, LAS unsigned char* lds, int unit) {
    const int tid = threadIdx.x, lane = tid & 63, w = __builtin_amdgcn_readfirstlane(tid >> 6), fr = lane & 15, fq = lane >> 4;
    const int nb = unit >> 3, g = unit & 7, row0 = nb * 128, c0 = g * 256;
    LAS float* stat = (LAS float*)lds; LAS bf16_t* vt = (LAS bf16_t*)(lds + 1024);
    LAS const bf16_t* wl = (LAS const bf16_t*)(lds + 69632);
    const bf16_t* AV = WSP(bf16_t, WS_AV); const bf16_t* AU = WSP(bf16_t, WS_AU); bf16_t* YA = WSP(bf16_t, WS_YA);
    f32x4 lp4[4]; { const float* lp = WSP(float, WS_LNP) + (size_t)(row0 + (tid >> 2)) * 64 + 16 * (tid & 3);
#pragma unroll
        for (int i = 0; i < 4; ++i) lp4[i] = *(const f32x4*)(lp + 4 * i); }
    u32x4 raw[8];
#pragma unroll
    for (int i = 0; i < 8; ++i) { const int idx = tid + 512 * i; raw[i] = *(const u32x4*)(AV + (size_t)(row0 + (idx >> 5)) * 2048 + c0 + 8 * (idx & 31)); }
    u32x2 uu[8][2];
#pragma unroll
    for (int m = 0; m < 8; ++m)
#pragma unroll
        for (int n = 0; n < 2; ++n) uu[m][n] = *(const u32x2*)(AU + (size_t)(row0 + 16 * m + fr) * 2048 + c0 + 32 * w + 16 * n + 4 * fq);
    { float s = 0.f, q = 0.f;
#pragma unroll
      for (int i = 0; i < 4; ++i) { s += lp4[i][0] + lp4[i][2]; q += lp4[i][1] + lp4[i][3]; }
      s += __shfl_xor(s, 1); q += __shfl_xor(q, 1); s += __shfl_xor(s, 2); q += __shfl_xor(q, 2);
      if ((tid & 3) == 0) { const float mu = s * (1.0f / 2048.0f), var = q * (1.0f / 2048.0f) - mu * mu; stat[2 * (tid >> 2)] = mu; stat[2 * (tid >> 2) + 1] = rsqrtf(fmaxf(var, 0.f) + EPS); } }
    __syncthreads();
#pragma unroll
    for (int i = 0; i < 8; ++i) { const int idx = tid + 512 * i, s = idx >> 5, cc = idx & 31;
        const f32x4 g0 = *(const f32x4*)(p.in[I_LNG] + c0 + 8 * cc), g1 = *(const f32x4*)(p.in[I_LNG] + c0 + 8 * cc + 4), b0 = *(const f32x4*)(p.in[I_LNB] + c0 + 8 * cc), b1 = *(const f32x4*)(p.in[I_LNB] + c0 + 8 * cc + 4);
        const float mu = stat[2 * s], rs = stat[2 * s + 1]; const u32x4 r = raw[i];
        u32x2 o0, o1;
        o0.x = cvt_pk_bf16((bflo(r.x) - mu) * rs * g0[0] + b0[0], (bfhi(r.x) - mu) * rs * g0[1] + b0[1]); o0.y = cvt_pk_bf16((bflo(r.y) - mu) * rs * g0[2] + b0[2], (bfhi(r.y) - mu) * rs * g0[3] + b0[3]);
        o1.x = cvt_pk_bf16((bflo(r.z) - mu) * rs * g1[0] + b1[0], (bfhi(r.z) - mu) * rs * g1[1] + b1[1]); o1.y = cvt_pk_bf16((bflo(r.w) - mu) * rs * g1[2] + b1[2], (bfhi(r.w) - mu) * rs * g1[3] + b1[3]);
        *(LAS u32x2*)(vt + s * 260 + 8 * cc) = o0; *(LAS u32x2*)(vt + s * 260 + 8 * cc + 4) = o1; }
    __syncthreads();
    f32x4 acc[8][2];
#pragma unroll
    for (int m = 0; m < 8; ++m) { acc[m][0] = (f32x4){0.f, 0.f, 0.f, 0.f}; acc[m][1] = (f32x4){0.f, 0.f, 0.f, 0.f}; }
#pragma unroll
    for (int ks = 0; ks < 4; ++ks) {
        bf16x8 bfr[2];
#pragma unroll
        for (int n = 0; n < 2; ++n) bfr[n] = tr_frag(vt, 260, 32 * ks, 32 * w + 16 * n, fr, fq);
#pragma unroll
        for (int m = 0; m < 8; ++m) {
            if (m < 4 && ks >= 2) continue;
            const bf16x8 afr = *(const LAS bf16x8*)(wl + (16 * m + fr) * 136 + 32 * ks + 8 * fq);
#pragma unroll
            for (int n = 0; n < 2; ++n) acc[m][n] = __builtin_amdgcn_mfma_f32_16x16x32_bf16(bfr[n], afr, acc[m][n], 0, 0, 0);
        }
    }
#pragma unroll
    for (int m = 0; m < 8; ++m) { const float bs = p.in[I_SGB][g * 128 + 16 * m + fr];
#pragma unroll
        for (int n = 0; n < 2; ++n) { const size_t offy = (size_t)(row0 + 16 * m + fr) * 4096 + c0 + 32 * w + 16 * n + 4 * fq; const u32x2 u = uu[m][n];
            u32x2 o; o.x = cvt_pk_bf16(bflo(u.x) * (acc[m][n][0] + bs), bfhi(u.x) * (acc[m][n][1] + bs)); o.y = cvt_pk_bf16(bflo(u.y) * (acc[m][n][2] + bs), bfhi(u.y) * (acc[m][n][3] + bs));
            if (MIX8 & 1) *(unsigned*)((unsigned char*)YA + offy) = cvt4_fp8(bflo(u.x) * (acc[m][n][0] + bs), bfhi(u.x) * (acc[m][n][1] + bs), bflo(u.y) * (acc[m][n][2] + bs), bfhi(u.y) * (acc[m][n][3] + bs));
            else *(u32x2*)(YA + offy) = o; } }
    __syncthreads();
}
__device__ __forceinline__ void prep_unit(const Params& p, LAS unsigned char* lds, int unit) {
    const int tid = threadIdx.x, lane = tid & 63, w = __builtin_amdgcn_readfirstlane(tid >> 6), fr = lane & 15, fq = lane >> 4;
    const int h = unit & 3, r0 = (unit >> 2) * 64;
    LAS float* part = (LAS float*)lds; LAS float* glr = (LAS float*)(lds + 32768); LAS float* tot = (LAS float*)(lds + 36864); LAS float* bl = (LAS float*)(lds + 37888);
    LAS bf16_t* qd = (LAS bf16_t*)(lds + 40960); LAS bf16_t* ki = (LAS bf16_t*)(lds + 40960 + 33792);
    const bf16_t* H = WSP(bf16_t, WS_H); const bf16_t* WG = WSP(bf16_t, WS_WG_T);
    { const bf16_t* Q = WSP(bf16_t, WS_Q); const bf16_t* Kk = WSP(bf16_t, WS_K);
#pragma unroll
      for (int i = 0; i < 4; ++i) { const int idx = tid + 512 * i, row = idx >> 5, ch = idx & 31; const size_t go = (size_t)(r0 + row) * 1024 + h * 256 + 8 * ch;
          const u32x4 qv = *(const u32x4*)(Q + go), kv = *(const u32x4*)(Kk + go); *(LAS u32x4*)(qd + row * 264 + 8 * ch) = qv; *(LAS u32x4*)(ki + row * 264 + 8 * ch) = kv; } }
    { f32x4 ga[4];
#pragma unroll
      for (int m = 0; m < 4; ++m) ga[m] = (f32x4){0.f, 0.f, 0.f, 0.f};
#pragma unroll 2
      for (int ks = 0; ks < 8; ++ks) { const int kk = 256 * w + 32 * ks + 8 * fq; const bf16x8 bfr = *(const bf16x8*)(WG + fr * 2048 + kk);
#pragma unroll
          for (int m = 0; m < 4; ++m) { const bf16x8 afr = *(const bf16x8*)(H + (size_t)(r0 + 16 * m + fr) * 2048 + kk); ga[m] = __builtin_amdgcn_mfma_f32_16x16x32_bf16(afr, bfr, ga[m], 0, 0, 0); } }
#pragma unroll
      for (int m = 0; m < 4; ++m)
#pragma unroll
          for (int r = 0; r < 4; ++r) part[(w * 64 + 16 * m + 4 * fq + r) * 16 + fr] = ga[m][r]; }
    __syncthreads();
    for (int idx = tid; idx < 1024; idx += 512) { float s = 0.f;
#pragma unroll
        for (int ww = 0; ww < 8; ++ww) s += part[ww * 1024 + idx];
        glr[idx] = s; }
    __syncthreads();
    const int kc = tid & 255, half = tid >> 8, kg = h * 256 + kc;
    float cs[32];
    { float w2[16];
#pragma unroll
      for (int j = 0; j < 16; ++j) w2[j] = p.in[I_GW2][j * 1024 + kg];
      const float gb = p.in[I_GGB][kg]; float run = 0.f;
#pragma unroll
      for (int i = 0; i < 32; ++i) { const int t = 32 * half + i; const LAS f32x4* g4 = (const LAS f32x4*)(glr + t * 16); float z = gb;
#pragma unroll
          for (int j = 0; j < 4; ++j) { const f32x4 gv = g4[j]; z += gv[0] * w2[4 * j] + gv[1] * w2[4 * j + 1] + gv[2] * w2[4 * j + 2] + gv[3] * w2[4 * j + 3]; }
          const float ls = fminf(z, 0.f) - __logf(1.0f + __expf(-fabsf(z))); run += ls * 0.0625f; cs[i] = run; }
      if (half == 0) tot[kc] = run;
      __syncthreads();
      const float off = half ? tot[kc] : 0.f;
      if (half == 1) bl[kc] = off + run;
#pragma unroll
      for (int i = 0; i < 32; ++i) cs[i] += off; }
    __syncthreads();
    const float blast = bl[kc];
    { unsigned kst[16];
#pragma unroll
      for (int i = 0; i < 32; i += 2) { float ksv[2];
#pragma unroll
          for (int ii = 0; ii < 2; ++ii) { const int t = 32 * half + i + ii; const float b = cs[i + ii];
              const float q = bf2f(qd[t * 264 + kc]), k = bf2f(ki[t * 264 + kc]); const float eb = __expf(b);
              const float qdv = q * 0.0625f * eb, kiv = k * __builtin_amdgcn_rcpf(eb); ksv[ii] = k * __expf(blast - b);
              qd[t * 264 + kc] = (bf16_t)(cvt_pk_bf16(qdv, 0.f) & 0xffffu); ki[t * 264 + kc] = (bf16_t)(cvt_pk_bf16(kiv, 0.f) & 0xffffu); }
          kst[i >> 1] = cvt_pk_bf16(ksv[0], ksv[1]); }
      u32x4* kd = (u32x4*)(WSP(bf16_t, WS_KST) + ((size_t)unit * 256 + kc) * 64 + 32 * half);
#pragma unroll
      for (int j = 0; j < 4; ++j) kd[j] = (u32x4){kst[4 * j], kst[4 * j + 1], kst[4 * j + 2], kst[4 * j + 3]};
      if (half == 0) WSP(float, WS_DC)[unit * 256 + kc] = __expf(blast); }
    __syncthreads();
    { bf16_t* QD = WSP(bf16_t, WS_QD);
#pragma unroll
      for (int i = 0; i < 4; ++i) { const int idx = tid + 512 * i, row = idx >> 5, ch = idx & 31; *(u32x4*)(QD + (size_t)(r0 + row) * 1024 + h * 256 + 8 * ch) = *(const LAS u32x4*)(qd + row * 264 + 8 * ch); } }
    { const int m = w >> 1, n0 = 2 * (w & 1); f32x4 aa[2] = {(f32x4){0.f, 0.f, 0.f, 0.f}, (f32x4){0.f, 0.f, 0.f, 0.f}};
#pragma unroll
      for (int ks = 0; ks < 8; ++ks) { const bf16x8 afr = *(const LAS bf16x8*)(qd + (16 * m + fr) * 264 + 32 * ks + 8 * fq);
#pragma unroll
          for (int nn = 0; nn < 2; ++nn) { const bf16x8 bfr = *(const LAS bf16x8*)(ki + (16 * (n0 + nn) + fr) * 264 + 32 * ks + 8 * fq);
              aa[nn] = __builtin_amdgcn_mfma_f32_16x16x32_bf16(bfr, afr, aa[nn], 0, 0, 0); } }
      bf16_t* ATT = WSP(bf16_t, WS_ATT);
#pragma unroll
      for (int nn = 0; nn < 2; ++nn) { const int t = 16 * m + fr, s0 = 16 * (n0 + nn) + 4 * fq; float v[4];
#pragma unroll
          for (int r = 0; r < 4; ++r) v[r] = (s0 + r <= t) ? aa[nn][r] : 0.f;
          u32x2 o; o.x = cvt_pk_bf16(v[0], v[1]); o.y = cvt_pk_bf16(v[2], v[3]); *(u32x2*)(ATT + ((size_t)unit * 64 + t) * 64 + s0) = o; } }
    __syncthreads();
}
struct ScanSet { u32x4 qraw[4]; u32x4 kraw[4]; u32x4 araw; u32x4 vraw; float dc; };
__device__ __forceinline__ void scan_load(ScanSet& F, const Params& p, int b, int h, int c, int vc0, int tid) {
    const int u = (b * 32 + c) * 4 + h, r0 = b * 2048 + c * 64;
    const bf16_t* QD = WSP(bf16_t, WS_QD) + (size_t)r0 * 1024 + h * 256; const bf16_t* KST = WSP(bf16_t, WS_KST) + (size_t)u * 256 * 64;
#pragma unroll
    for (int i = 0; i < 4; ++i) { const int idx = tid + 512 * i; F.qraw[i] = *(const u32x4*)(QD + (size_t)(idx >> 5) * 1024 + 8 * (idx & 31)); F.kraw[i] = *(const u32x4*)(KST + (size_t)idx * 8); }
    F.araw = *(const u32x4*)(WSP(bf16_t, WS_ATT) + ((size_t)u * 64 + (tid >> 3)) * 64 + 8 * (tid & 7));
    F.vraw = *(const u32x4*)(WSP(bf16_t, WS_V) + (size_t)(r0 + (tid >> 3)) * 2048 + vc0 + 8 * (tid & 7));
    F.dc = WSP(float, WS_DC)[u * 256 + (tid & 255)];
}
__device__ __forceinline__ void scan_step(ScanSet& cur, int cnext, f32x4 (&sS)[2][4], const Params& p, LAS unsigned char* lds, int b, int h, int c, int vc0, int w, int fr, int fq, int tid) {
    LAS bf16_t* st = (LAS bf16_t*)lds;
    LAS bf16_t* vt = (LAS bf16_t*)(lds + 33792);
    LAS bf16_t* qd = (LAS bf16_t*)(lds + 43008);
    LAS bf16_t* at = (LAS bf16_t*)(lds + 76800);
    LAS bf16_t* kt = (LAS bf16_t*)(lds + 86016);
    LAS float* dcs = (LAS float*)(lds + 122880);
    const int rt = w >> 1, cp = w & 1;
#pragma unroll
    for (int i = 0; i < 2; ++i)
#pragma unroll
        for (int n = 0; n < 4; ++n) { u32x2 o; o.x = cvt_pk_bf16(sS[i][n][0], sS[i][n][1]); o.y = cvt_pk_bf16(sS[i][n][2], sS[i][n][3]);
            *(LAS u32x2*)(st + (16 * n + fr) * 264 + 32 * w + 16 * i + 4 * fq) = o; }
    *(LAS u32x4*)(vt + (tid >> 3) * 72 + 8 * (tid & 7)) = cur.vraw;
#pragma unroll
    for (int i = 0; i < 4; ++i) { const int idx = tid + 512 * i; *(LAS u32x4*)(qd + (idx >> 5) * 264 + 8 * (idx & 31)) = cur.qraw[i]; *(LAS u32x4*)(kt + (idx >> 3) * 72 + 8 * (idx & 7)) = cur.kraw[i]; }
    *(LAS u32x4*)(at + (tid >> 3) * 72 + 8 * (tid & 7)) = cur.araw;
    if (tid < 256) dcs[tid] = cur.dc;
    scan_load(cur, p, b, h, cnext, vc0, tid);
    __syncthreads();
    bf16_t* O = WSP(bf16_t, WS_O);
    bf16x8 afr[2];
#pragma unroll
    for (int ks = 0; ks < 2; ++ks) afr[ks] = *(const LAS bf16x8*)(at + (16 * rt + fr) * 72 + 32 * ks + 8 * fq);
    f32x4 dcv[2]; dcv[0] = *(const LAS f32x4*)(dcs + 32 * w + 4 * fq); dcv[1] = *(const LAS f32x4*)(dcs + 32 * w + 16 + 4 * fq);
    bf16x8 kf[2][2];
#pragma unroll
    for (int i = 0; i < 2; ++i)
#pragma unroll
        for (int ks = 0; ks < 2; ++ks) kf[i][ks] = *(const LAS bf16x8*)(kt + (32 * w + 16 * i + fr) * 72 + 32 * ks + 8 * fq);
#pragma unroll
    for (int n = 0; n < 4; ++n) { bf16x8 vf[2];
#pragma unroll
        for (int ks = 0; ks < 2; ++ks) vf[ks] = tr_frag(vt, 72, 32 * ks, 16 * n, fr, fq);
        if ((n >> 1) == cp) { const int ct = n;
            f32x4 ao = (f32x4){0.f, 0.f, 0.f, 0.f};
#pragma unroll
            for (int ks = 0; ks < 8; ++ks) { const bf16x8 sfr = *(const LAS bf16x8*)(st + (16 * ct + fr) * 264 + 32 * ks + 8 * fq), qfr = *(const LAS bf16x8*)(qd + (16 * rt + fr) * 264 + 32 * ks + 8 * fq); ao = __builtin_amdgcn_mfma_f32_16x16x32_bf16(sfr, qfr, ao, 0, 0, 0); }
#pragma unroll
            for (int ks = 0; ks < 2; ++ks) ao = __builtin_amdgcn_mfma_f32_16x16x32_bf16(vf[ks], afr[ks], ao, 0, 0, 0);
            u32x2 o; o.x = cvt_pk_bf16(ao[0], ao[1]); o.y = cvt_pk_bf16(ao[2], ao[3]);
            *(u32x2*)(O + (size_t)(b * 2048 + c * 64 + 16 * rt + fr) * 2048 + vc0 + 16 * ct + 4 * fq) = o; }
#pragma unroll
        for (int i = 0; i < 2; ++i) { sS[i][n] = sS[i][n] * dcv[i];
#pragma unroll
            for (int ks = 0; ks < 2; ++ks) sS[i][n] = __builtin_amdgcn_mfma_f32_16x16x32_bf16(kf[i][ks], vf[ks], sS[i][n], 0, 0, 0); } }
    __syncthreads();
}
__device__ __forceinline__ void scan_unit(const Params& p, LAS unsigned char* lds, int unit) {
    const int tid = threadIdx.x, lane = tid & 63, w = __builtin_amdgcn_readfirstlane(tid >> 6), fr = lane & 15, fq = lane >> 4;
    const int sl = unit & 7, h = (unit >> 3) & 3, b = unit >> 5, vc0 = h * 512 + sl * 64;
    f32x4 sS[2][4];
#pragma unroll
    for (int i = 0; i < 2; ++i)
#pragma unroll
        for (int n = 0; n < 4; ++n) sS[i][n] = (f32x4){0.f, 0.f, 0.f, 0.f};
    ScanSet A, B;
    scan_load(A, p, b, h, 0, vc0, tid); scan_load(B, p, b, h, 1, vc0, tid);
#pragma unroll 1
    for (int c = 0; c < 32; c += 2) {
        scan_step(A, c + 2 < 32 ? c + 2 : 31, sS, p, lds, b, h, c, vc0, w, fr, fq, tid);
        scan_step(B, c + 3 < 32 ? c + 3 : 31, sS, p, lds, b, h, c + 1, vc0, w, fr, fq, tid);
    }
}
__device__ __forceinline__ void p5_yb(const Params& p) {
    const int tid = threadIdx.x, lane = tid & 63, wave = tid >> 6, gw = blockIdx.x * NWAVES + wave, NGW = gridDim.x * NWAVES;
    const f32x4 g0 = *(const f32x4*)(p.in[I_GNG] + 8 * lane), g1 = *(const f32x4*)(p.in[I_GNG] + 8 * lane + 4);
    for (int m = gw; m < NTOK; m += NGW) {
#pragma unroll
        for (int hh = 0; hh < 4; ++hh) { const size_t off = (size_t)m * 2048 + hh * 512 + 8 * lane;
            const u32x4 o = *(const u32x4*)(WSP(bf16_t, WS_O) + off), r = *(const u32x4*)(WSP(bf16_t, WS_R) + off);
            float v[8] = {bflo(o.x), bfhi(o.x), bflo(o.y), bfhi(o.y), bflo(o.z), bfhi(o.z), bflo(o.w), bfhi(o.w)};
            float s = 0.f;
#pragma unroll
            for (int j = 0; j < 8; ++j) s += v[j] * v[j];
            const float rstd = rsqrtf(wave_sum(s) * (1.0f / 512.0f) + EPS);
            const float rr[8] = {bflo(r.x), bfhi(r.x), bflo(r.y), bfhi(r.y), bflo(r.z), bfhi(r.z), bflo(r.w), bfhi(r.w)};
            f32x4 y0, y1;
#pragma unroll
            for (int j = 0; j < 4; ++j) { y0[j] = v[j] * rstd * g0[j] * rr[j]; y1[j] = v[4 + j] * rstd * g1[j] * rr[4 + j]; }
            if (MIX8 & 1) { u32x2 w8; w8.x = cvt4_fp8(y0[0], y0[1], y0[2], y0[3]); w8.y = cvt4_fp8(y1[0], y1[1], y1[2], y1[3]); *(u32x2*)(WSP(unsigned char, WS_YA) + (size_t)m * 4096 + 2048 + hh * 512 + 8 * lane) = w8; }
            else *(u32x4*)(WSP(bf16_t, WS_YA) + (size_t)m * 4096 + 2048 + hh * 512 + 8 * lane) = pack8(y0, y1); }
    }
}
__device__ __forceinline__ void router_item(const Params& p, LAS unsigned char* lds, int item) {
    const int tid = threadIdx.x, lane = tid & 63, w = __builtin_amdgcn_readfirstlane(tid >> 6);
    const int R0 = item * 32, b = R0 >> 11;
    LAS float* pl = (LAS float*)lds; LAS float* sq = (LAS float*)(lds + 32768); LAS float* lg = (LAS float*)(lds + 33792); LAS float* rs = (LAS float*)(lds + 38400);
    LAS int* lcnt = (LAS int*)(lds + 38656); LAS int* lbase = (LAS int*)(lds + 38912);
    if (tid < 32) lcnt[tid] = 0;
    const float* X1 = WSP(float, WS_X1);
    { f32x16 acc;
#pragma unroll
      for (int i = 0; i < 16; ++i) acc[i] = 0.f;
      float ssq = 0.f; const int row = lane & 31, hi = lane >> 5;
      const float* xr = X1 + (size_t)(R0 + row) * 2048 + 256 * w + 4 * hi;
      const float* br = WSP(float, WS_RWP) + (size_t)b * 65536 + (size_t)(256 * w + 4 * hi) * 32 + row;
#pragma unroll 4
      for (int kb = 0; kb < 256; kb += 8) { const f32x4 va = *(const f32x4*)(xr + kb); ssq += (va[0] * va[0] + va[1] * va[1]) + (va[2] * va[2] + va[3] * va[3]);
#pragma unroll
          for (int j = 0; j < 4; ++j) acc = __builtin_amdgcn_mfma_f32_32x32x2f32(va[j], br[(kb + j) * 32], acc, 0, 0, 0); }
      ssq += __shfl_xor(ssq, 32);
      if (lane < 32) sq[w * 32 + lane] = ssq;
#pragma unroll
      for (int r = 0; r < 16; ++r) pl[(w * 32 + (r & 3) + 8 * (r >> 2) + 4 * hi) * 32 + row] = acc[r]; }
    __syncthreads();
#pragma unroll
    for (int q = 0; q < 2; ++q) { const int idx = tid + 512 * q, r = idx >> 5, e = idx & 31; float s = 0.f, ss = 0.f;
#pragma unroll
        for (int ww = 0; ww < 8; ++ww) { s += pl[ww * 1024 + idx]; ss += sq[ww * 32 + r]; }
        const float rstd = rsqrtf(ss * (1.0f / 2048.0f) + EPS); lg[r * 33 + e] = s * rstd + WSP(float, WS_BIASP)[b * 32 + e]; if (e == 0) rs[r] = rstd; }
    __syncthreads();
    int ek[4] = {0, 0, 0, 0}, rk[4] = {0, 0, 0, 0}; float wk[4] = {0.f, 0.f, 0.f, 0.f};
    if (tid < 32) { unsigned taken = 0u; float lv[4];
#pragma unroll
        for (int k = 0; k < 4; ++k) { float best = -3.0e38f; int bi = 0;
            for (int e = 0; e < 32; ++e) { const float x = lg[tid * 33 + e]; if (!((taken >> e) & 1u) && x > best) { best = x; bi = e; } }
            taken |= 1u << bi; ek[k] = bi; lv[k] = best; }
        float sum = 0.f;
#pragma unroll
        for (int k = 0; k < 4; ++k) { wk[k] = expf(lv[k] - lv[0]); sum += wk[k]; }
#pragma unroll
        for (int k = 0; k < 4; ++k) { wk[k] /= sum; rk[k] = __hip_atomic_fetch_add(&lcnt[ek[k]], 1, __ATOMIC_RELAXED, __HIP_MEMORY_SCOPE_WORKGROUP); } }
    __syncthreads();
    if (tid < 32) { const int c = lcnt[tid]; lbase[tid] = c ? (int)__hip_atomic_fetch_add((unsigned*)WSP(unsigned, WS_CTL) + CW_CNT + tid, (unsigned)c, __ATOMIC_RELAXED, __HIP_MEMORY_SCOPE_AGENT) : 0; }
    __syncthreads();
    if (tid < 32) {
#pragma unroll
        for (int k = 0; k < 4; ++k) { const int pos = lbase[ek[k]] + rk[k], slot = (R0 + tid) * 4 + k; WSP(int, WS_LIST)[ek[k] * 8192 + pos] = slot; WSP(float, WS_TOPW)[slot] = wk[k]; } }
    const float* MOD = WSP(float, WS_MOD) + b * 12288;
#pragma unroll
    for (int rr = 0; rr < 4; ++rr) { const int r = 4 * w + rr; const float rstd = rs[r]; const size_t ro = (size_t)(R0 + r) * 2048;
#pragma unroll
        for (int j = 0; j < 4; ++j) { const int c = 8 * lane + 512 * j; f32x4 o[2];
#pragma unroll
            for (int q = 0; q < 2; ++q) { const f32x4 x = *(const f32x4*)(X1 + ro + c + 4 * q), g = *(const f32x4*)(p.in[I_N2G] + c + 4 * q), sc = *(const f32x4*)(MOD + 4 * 2048 + c + 4 * q), sh = *(const f32x4*)(MOD + 3 * 2048 + c + 4 * q);
                o[q] = x * rstd * g * (sc + 1.0f) + sh; }
            u32x2 w8; w8.x = cvt4_fp8(o[0][0], o[0][1], o[0][2], o[0][3]); w8.y = cvt4_fp8(o[1][0], o[1][1], o[1][2], o[1][3]); *(u32x2*)(WSP(unsigned char, WS_H) + ro + c) = w8; } }
    __syncthreads();
}
__device__ __forceinline__ int moe_tables(const Params& p, LAS int* tab) {
    const int tid = threadIdx.x;
    if (tid < 32) tab[tid] = (int)__hip_atomic_load((unsigned*)WSP(unsigned, WS_CTL) + CW_CNT + tid, __ATOMIC_RELAXED, __HIP_MEMORY_SCOPE_AGENT);
    __syncthreads();
    if (tid == 0) { int a = 0; for (int e = 0; e < 32; ++e) { tab[32 + e] = a; const int n = (tab[e] + 255) >> 8; for (int j = 0; j < n; ++j) tab[72 + a + j] = e; a += n; } tab[64] = a; }
    __syncthreads();
    return tab[64];
}
__device__ __forceinline__ void p11_final(const Params& p) {
    const int tid = threadIdx.x, lane = tid & 63, wave = tid >> 6, gw = blockIdx.x * NWAVES + wave, NGW = gridDim.x * NWAVES;
    const float* X1 = WSP(float, WS_X1); const bf16_t* Y = WSP(bf16_t, WS_Y); const float* TW = WSP(float, WS_TOPW);
    for (int m = gw; m < NTOK; m += NGW) {
        const int b = m >> 11; const float* gt2 = WSP(float, WS_MOD) + b * 12288 + 5 * 2048;
        const f32x4 wk = *(const f32x4*)(TW + 4 * m);
        f32x4 x2[4][2]; float s = 0.f;
#pragma unroll
        for (int j = 0; j < 4; ++j) { const int c = 8 * lane + 512 * j; f32x4 mo[2] = {(f32x4){0.f, 0.f, 0.f, 0.f}, (f32x4){0.f, 0.f, 0.f, 0.f}};
#pragma unroll
            for (int k = 0; k < 4; ++k) { const u32x4 y = *(const u32x4*)(Y + ((size_t)m * 4 + k) * 2048 + c); const float wv = wk[k];
                mo[0][0] += wv * bflo(y.x); mo[0][1] += wv * bfhi(y.x); mo[0][2] += wv * bflo(y.y); mo[0][3] += wv * bfhi(y.y);
                mo[1][0] += wv * bflo(y.z); mo[1][1] += wv * bfhi(y.z); mo[1][2] += wv * bflo(y.w); mo[1][3] += wv * bfhi(y.w); }
#pragma unroll
            for (int q = 0; q < 2; ++q) { const f32x4 x = *(const f32x4*)((DBG_MODE == 1 ? p.in[I_X] : X1) + (size_t)m * 2048 + c + 4 * q), g = *(const f32x4*)(gt2 + c + 4 * q); const f32x4 v = (DBG_MODE == 0) ? x + g * mo[q] : x; x2[j][q] = v;
                s += (v[0] * v[0] + v[1] * v[1]) + (v[2] * v[2] + v[3] * v[3]); } }
        const float rstd = rsqrtf(wave_sum(s) * (1.0f / 2048.0f) + EPS);
#pragma unroll
        for (int j = 0; j < 4; ++j)
#pragma unroll
            for (int q = 0; q < 2; ++q) { const int c = 8 * lane + 512 * j + 4 * q; *(f32x4*)(p.out + (size_t)m * 2048 + c) = x2[j][q] * rstd * *(const f32x4*)(p.in[I_FG] + c); }
    }
}


__device__ __forceinline__ void dbg_out(const Params& p, int mode) {
    const size_t n = (size_t)NTOK * 2048;
    for (size_t i = (size_t)blockIdx.x * 512 + threadIdx.x; i < n; i += (size_t)gridDim.x * 512) {
        const size_t m = i >> 11, c = i & 2047; float v = 0.f;
        if (mode == 3) v = bf2f(WSP(bf16_t, WS_H)[i]) + WSP(float, WS_MOD)[i % 49152] + WSP(float, WS_RWP)[i % 262144] + bf2f(WSP(bf16_t, WS_WIN_T)[i]) + bf2f(WSP(bf16_t, WS_WA_T)[i % 4194304]) + bf2f(WSP(bf16_t, WS_WG_T)[i % 32768]);
        if (mode == 4) v = bf2f(WSP(bf16_t, WS_AU)[i]) + bf2f(WSP(bf16_t, WS_AV)[i]) + bf2f(WSP(bf16_t, WS_V)[i]) + bf2f(WSP(bf16_t, WS_R)[i]) + bf2f(WSP(bf16_t, WS_GA)[i]) + bf2f(WSP(bf16_t, WS_GB)[i]) + bf2f(WSP(bf16_t, WS_Q)[m * 1024 + (c & 1023)]) + bf2f(WSP(bf16_t, WS_K)[m * 1024 + (c & 1023)]) + WSP(float, WS_LNP)[i % 524288];
        if (mode == 5) v = bf2f(WSP(bf16_t, WS_YA)[i]);
        if (mode == 6) v = bf2f(WSP(bf16_t, WS_QD)[i % 8388608]) + bf2f(WSP(bf16_t, WS_KST)[i % 8388608]) + bf2f(WSP(bf16_t, WS_ATT)[i % 2097152]) + WSP(float, WS_DC)[i % 131072];
        if (mode == 7) v = bf2f(WSP(bf16_t, WS_O)[i]);
        if (mode == 8) v = bf2f(WSP(bf16_t, WS_YB)[i]) + WSP(float, WS_M1)[i];
        if (mode == 9) v = bf2f(WSP(bf16_t, WS_MERGED)[i]);
        p.out[i] = v;
    }
}

constexpr int PER_PHASE = 12;
constexpr int N_LAUNCHES = MK_N_LAUNCHES;
__global__ void __launch_bounds__(NWAVES * 64, 2) fwd_kernel(Params p) {
    extern __shared__ __attribute__((aligned(16))) unsigned char lds_raw[];
    LAS unsigned char* lds = (LAS unsigned char*)lds_raw;
    const int tid = threadIdx.x, G = gridDim.x;
    for (int u = tid; u < (TAB_OFF - LDSCTL_OFF) / 4; u += NWAVES * 64) ((LAS unsigned*)(lds + LDSCTL_OFF))[u] = 0u;
    __syncthreads();
    unsigned* ctl = WSP(unsigned, WS_CTL);
    XcdBarrier bar; bar.bar = ctl + CW_BAR; bar.x = 0; bar.st = nullptr;
    if (N_LAUNCHES == 1) bar = xcd_barrier_post(ctl + CW_BAR, (volatile LAS unsigned*)(lds + MISC_OFF) + 8);
    const int lo = p.ph_lo, hi = p.ph_hi;
#define IN(k) (lo <= (k) && (k) < hi)
#define SEAM(k) do { if (IN(k) && IN((k) + 1)) xcd_barrier(bar); } while (0)

    if (IN(0)) { p0_prologue(p, lds); }
    SEAM(0);
    if (IN(1)) { p1_norm1(p); }
    SEAM(1);
    if (IN(2)) {
        if (PROJ8_PN0 > 0) { DenseSched S; S.o.init(NTOK / 256, PROJ8_PN0, G, blockIdx.x); S.A = (const char*)WSP(bf16_t, WS_H); S.Bt = (const char*)WSP(bf16_t, WS_WIN_T); S.K = 2048;
            EpiProj E{p.ws, false}; pg8::gemm_phase<EpiProj, DenseSched>(lds, S, E, 2048); }
        if (PROJ8_PN0 < 56) { DenseSched8 S; S.o.init(NTOK / 256, 56 - PROJ8_PN0, G, blockIdx.x); S.A = (const char*)WSP(unsigned char, WS_H8); S.Bt = (const char*)WSP(unsigned char, WS_WIN8); S.K = 2048; S.pn0 = PROJ8_PN0;
            EpiProj E{p.ws, true}; pg8::gemm_phase<EpiProj, DenseSched8>(lds, S, E, 2048); }
    }
    SEAM(2);
    if (IN(3)) {
        if (G == 256) { const int x = blockIdx.x & 7, sidx = blockIdx.x >> 3;
            for (int i = 0; i < 2; ++i) { const int j = sidx * 2 + i; prep_unit(p, lds, ((((x >> 1) * 32 + (j >> 1)) << 2) | (2 * (x & 1) + (j & 1)))); } }
        else for (int u = blockIdx.x; u < 512; u += G) prep_unit(p, lds, u);
    }
    SEAM(3);
    if (IN(4)) {
        const int half = G >> 1, x = blockIdx.x & 7, sidx = blockIdx.x >> 3;
        if (G == 256) {
            if (!(sidx & 1)) { const int s16 = sidx >> 1; for (int r_ = 0; r_ < REP_SCAN; ++r_) scan_unit(p, lds, ((x * 2 + (s16 >> 3)) << 3) | (s16 & 7)); }
            else { const int j = (sidx >> 1) * 8 + x; sg_load_w(p, lds, j & 7); for (int r_ = 0; r_ < REP_SG; ++r_) for (int u = j; u < 512; u += half) sg_unit(p, lds, u);
                const int wv = __builtin_amdgcn_readfirstlane(tid >> 6); xp_run<false>(p, lds + wv * 8192, j * 8 + wv, 1024, XSPLIT / 1024, tid & 63); }
        } else { for (int u = blockIdx.x; u < 128; u += G) scan_unit(p, lds, u); for (int u = blockIdx.x; u < 512; u += G) { __syncthreads(); sg_load_w(p, lds, u & 7); sg_unit(p, lds, u); } }
    }
    SEAM(4);
    if (IN(5)) { p5_yb(p); }
    SEAM(5);
    if (IN(6)) {
        SchedM S; S.o.init(NTOK / 256, 8, G, blockIdx.x); S.A = (const char*)WSP(bf16_t, WS_YA); S.Bt = (const char*)WSP(bf16_t, WS_WA_T); S.K = 4096;
        EpiMerge E{WSP(bf16_t, WS_GA), WSP(bf16_t, WS_GB), WSP(bf16_t, WS_MERGED)};
        pg8::gemm_phase<EpiMerge, SchedM>(lds, S, E, 4096);
    }
    SEAM(6);
    if (IN(7)) {
        SchedO S; S.o.init(NTOK / 256, 8, G, blockIdx.x); S.A = (const char*)WSP(bf16_t, WS_MERGED); S.Bt = (const char*)WSP(bf16_t, WS_WOUT_T); S.K = 2048;
        EpiOut E{p.in[I_X], WSP(float, WS_MOD), WSP(float, WS_X1)};
        pg8::gemm_phase<EpiOut, SchedO>(lds, S, E, 2048);
    }
    SEAM(7);
    if (IN(8)) { for (int it = blockIdx.x; it < NTOK / 32; it += G) router_item(p, lds, it); }
    SEAM(8);
    if (IN(9)) {
        LAS int* tab = (LAS int*)(lds + TAB_OFF); LAS unsigned* goff = (LAS unsigned*)(lds + TAB_OFF + 1024);
        const int NT = moe_tables(p, tab);
        const int units = NT * 16, R = (units + G - 1) / G, need = (units + R - 1) / R; const bool split = (G == 256 && G - need >= 16);
        const int wv9 = __builtin_amdgcn_readfirstlane(tid >> 6);
        if (G == 256) { const int nconv = split ? (G - need) * NWAVES : G * NWAVES, first = split ? ((int)blockIdx.x - need) * NWAVES + wv9 : (int)blockIdx.x * NWAVES + wv9;
            if (!split || (int)blockIdx.x >= need) xp_run<true>(p, lds + wv9 * 8192, first, nconv, (DSPLIT_ITEMS - first + nconv - 1) / nconv, tid & 63);
            __syncthreads(); }
        const int Geff = split ? need : G;
        if (!split || (int)blockIdx.x < need) {
        Moe1Sched S; S.o.init(NT, 16, Geff, blockIdx.x); S.A = (const char*)WSP(bf16_t, WS_H); S.W = (const char*)WSP(bf16_t, WS_WGU_T); S.tab = tab; S.goff = goff;
        for (int i = 0; i < 10; ++i) { int pm, pn; if (!S.o.idx(i, pm, pn)) break; const int e = tab[72 + pm], rt = pm - tab[32 + e], cnt = tab[e];
            for (int r = tid; r < 256; r += NWAVES * 64) { const int pos = rt * 256 + r; const int tok = pos < cnt ? (WSP(int, WS_LIST)[e * 8192 + pos] >> 2) : 0; goff[i * 256 + r] = (unsigned)tok * 2048u; } }
        __syncthreads();
        EpiAct E{p.in[I_EBG], p.in[I_EBU], WSP(bf16_t, WS_ACT)};
        pg8::gemm_phase<EpiAct, Moe1Sched>(lds, S, E, 2048);
        }
    }
    SEAM(9);
    if (IN(10)) {
        LAS int* tab = (LAS int*)(lds + TAB_OFF);
        const int NT = moe_tables(p, tab);
        Moe2Sched S; S.o.init(NT, 8, G, blockIdx.x); S.A = (const char*)WSP(bf16_t, WS_ACT); S.W = (const char*)WSP(bf16_t, WS_WDN_T); S.tab = tab;
        EpiDown E{p.in[I_EBD], WSP(bf16_t, WS_Y), WSP(int, WS_LIST), tab};
        pg8::gemm_phase<EpiDown, Moe2Sched>(lds, S, E, 2048);
    }
    SEAM(10);
    if (IN(11)) { if (DBG_MODE >= 3) dbg_out(p, DBG_MODE); else p11_final(p); }
#undef IN
#undef SEAM
}

extern "C" void kernel_launch(void* const* d_in, const int* in_sizes, int n_in, void* d_out, int out_size, void* d_ws, size_t ws_size, hipStream_t stream) {
    static int grid = 0;
    if (grid == 0) {
        if (n_in != 26 || out_size != NTOK * DM || ws_size < WS_END) { fprintf(stderr, "kernel_launch: unexpected shapes (n_in %d, out %d, ws %zu); nothing launched\n", n_in, out_size, ws_size); grid = -1; return; }
        int dev = 0, cus = 0, per_cu = 0;
        if (hipGetDevice(&dev) != hipSuccess || hipDeviceGetAttribute(&cus, hipDeviceAttributeMultiprocessorCount, dev) != hipSuccess) { grid = -1; return; }
        if (hipFuncSetAttribute((const void*)fwd_kernel, hipFuncAttributeMaxDynamicSharedMemorySize, LDS_BYTES) != hipSuccess) { fprintf(stderr, "kernel_launch: hipFuncSetAttribute failed\n"); grid = -1; return; }
        if (hipOccupancyMaxActiveBlocksPerMultiprocessor(&per_cu, (const void*)fwd_kernel, NWAVES * 64, LDS_BYTES) != hipSuccess || per_cu < 1) { fprintf(stderr, "kernel_launch: occupancy query says %d blocks per CU\n", per_cu); }
        (void)hipGetLastError();
        grid = cus;
    }
    if (grid < 0) return;
    if (hipMemsetAsync((char*)d_ws + WS_CTL, 0, CTL_ZERO_BYTES, stream) != hipSuccess) return;
    Params a{};
    for (int i = 0; i < 26; ++i) a.in[i] = (const float*)d_in[i];
    a.out = (float*)d_out; a.ws = (unsigned char*)d_ws;
    for (int li = 0; li < N_LAUNCHES; ++li) {
        if (DBG_MODE == 1 && li != 11) continue;
        if (DBG_MODE == 2 && li >= 8 && li != 11) continue;
        { const int lastph[10] = {11, 11, 7, 1, 2, 3, 3, 4, 5, 6}; if (DBG_MODE >= 3 && li > lastph[DBG_MODE] && li != 11) continue; }
        a.ph_lo = (N_LAUNCHES == 1) ? 0 : li; a.ph_hi = (N_LAUNCHES == 1) ? PER_PHASE : li + 1; a.li = li; a.pad = 0;
        for (int rep_ = 0; rep_ <= ((REPEAT_MASK >> li) & 1); ++rep_) {
            if (rep_ && li == 8) (void)hipMemsetAsync((char*)d_ws + WS_CTL + CW_CNT * 4, 0, 128, stream);
        hipLaunchKernelGGL(fwd_kernel, dim3(grid), dim3(NWAVES * 64), LDS_BYTES, stream, a);
        }
        const hipError_t le = hipPeekAtLastError();
        if (le != hipSuccess) { fprintf(stderr, "kernel_launch: launch %d failed: %s\n", li, hipGetErrorName(le)); break; }
    }
}
```

```cpp
#include <hip/hip_runtime.h>
#include <cstdio>
#include <cstdint>

#ifndef DBG_MODE
#define DBG_MODE 0
#endif
#ifndef REPEAT_MASK
#define REPEAT_MASK 0
#endif
#ifndef REP_SCAN
#define REP_SCAN 1
#endif
#ifndef REP_SG
#define REP_SG 1
#endif
#ifndef PROJ8_PN0
#define PROJ8_PN0 0
#endif
#ifndef MIX8
#define MIX8 5
#endif
#ifndef MK_N_LAUNCHES
#define MK_N_LAUNCHES 1
#endif

#define LAS __attribute__((address_space(3)))
#define GAS __attribute__((address_space(1)))
typedef unsigned short bf16_t;
typedef short bf16x8 __attribute__((ext_vector_type(8)));
typedef float f32x4 __attribute__((ext_vector_type(4)));
typedef float f32x2 __attribute__((ext_vector_type(2)));
typedef float f32x16 __attribute__((ext_vector_type(16)));
typedef unsigned u32x4 __attribute__((ext_vector_type(4)));
typedef unsigned u32x2 __attribute__((ext_vector_type(2)));
typedef int i32x4 __attribute__((ext_vector_type(4)));
typedef int i32x8 __attribute__((ext_vector_type(8)));
typedef GAS unsigned gu32;
#define RLX_AGENT __ATOMIC_RELAXED, __HIP_MEMORY_SCOPE_AGENT

constexpr int DM = 2048, NB = 4, SEQ = 2048, NTOK = NB * SEQ;
constexpr int NPROJ = 14336;
constexpr int INW = 14352;
constexpr int NEXP = 32, TOPK = 4, NSLOT = NTOK * TOPK;
constexpr int MAXTILE = 160;
constexpr float EPS = 1e-6f;

constexpr size_t MiB = 1u << 20;
constexpr size_t WS_CTL = 0, CTL_ZERO_BYTES = 128 * 1024;
constexpr size_t WS_MOD = 2 * MiB;
constexpr size_t WS_RWP = 3 * MiB;
constexpr size_t WS_BIASP = 4 * MiB;
constexpr size_t WS_WG_T = 4 * MiB + 4096;
constexpr size_t WS_LNP = 5 * MiB;
constexpr size_t WS_DC = 7 * MiB;
constexpr size_t WS_TOPW = 8 * MiB;
constexpr size_t WS_LIST = 9 * MiB;
constexpr size_t WS_WIN_T = 16 * MiB;
constexpr size_t WS_WA_T = 72 * MiB, WS_WB_T = 80 * MiB, WS_WOUT_T = 88 * MiB;
constexpr size_t WS_WGU_T = 96 * MiB;
constexpr size_t WS_WDN_T = 608 * MiB;
constexpr size_t WS_H = 864 * MiB;
constexpr size_t WS_AU = 896 * MiB, WS_AV = 928 * MiB, WS_Q = 960 * MiB, WS_K = 976 * MiB, WS_V = 992 * MiB, WS_R = 1024 * MiB, WS_GA = 1056 * MiB, WS_GB = 1088 * MiB;
constexpr size_t WS_QD = 1120 * MiB, WS_KST = 1136 * MiB, WS_ATT = 1152 * MiB;
constexpr size_t WS_O = 1160 * MiB, WS_YA = 1192 * MiB, WS_YB = 1224 * MiB, WS_MERGED = 1256 * MiB, WS_X1 = 1288 * MiB, WS_M1 = 1352 * MiB;
constexpr size_t WS_H8 = WS_M1;
constexpr size_t WS_WIN8 = WS_M1 + 16 * MiB;
constexpr size_t WS_HS = 10 * MiB;
constexpr size_t WS_WS = 10 * MiB + 65536;
constexpr int CW_CMAX = 16384;
constexpr size_t WS_ACT = 1416 * MiB;
constexpr size_t WS_Y = 1576 * MiB;
constexpr size_t WS_END = 1704 * MiB;
constexpr int CW_TMO = 0, CW_CODE = 1, CW_CNT = 64, CW_BAR = 4096;

constexpr int RING_BYTES = 131072;
constexpr int LDSCTL_OFF = RING_BYTES, MISC_OFF = LDSCTL_OFF + 320;
constexpr int TAB_OFF = RING_BYTES + 1024;
constexpr int LDS_BYTES = 147456;

typedef __bf16 bf16x2_t __attribute__((ext_vector_type(2)));
__device__ __forceinline__ unsigned cvt_pk_bf16(float lo, float hi) { const f32x2 v = {lo, hi}; const bf16x2_t b = __builtin_convertvector(v, bf16x2_t); unsigned r; __builtin_memcpy(&r, &b, 4); return r; }
__device__ __forceinline__ float bf2f(unsigned short b) { return __uint_as_float(((unsigned)b) << 16); }
__device__ __forceinline__ float bflo(unsigned w) { return __uint_as_float(w << 16); }
__device__ __forceinline__ float bfhi(unsigned w) { return __uint_as_float(w & 0xffff0000u); }
__device__ __forceinline__ float fast_sigmoid(float x) { return __builtin_amdgcn_rcpf(1.0f + __expf(-x)); }
__device__ __forceinline__ float gelu_tanh(float x) { const float u = 0.7978845608f * (x + 0.044715f * x * x * x); return x * fast_sigmoid(2.0f * u); }
__device__ __forceinline__ float wave_sum(float v) {
#pragma unroll
    for (int o = 1; o < 64; o <<= 1) v += __shfl_xor(v, o);
    return v;
}

typedef short s16x4 __attribute__((ext_vector_type(4)));
__device__ __forceinline__ bf16x8 tr_frag(const LAS bf16_t* tile, int pitch, int row0, int col0, int fr, int fq) {
    const LAS bf16_t* a = tile + (row0 + 8 * fq + (fr >> 2)) * pitch + col0 + 4 * (fr & 3);
    const s16x4 lo = __builtin_amdgcn_ds_read_tr16_b64_v4i16((LAS s16x4*)a), hi = __builtin_amdgcn_ds_read_tr16_b64_v4i16((LAS s16x4*)(a + 4 * pitch));
    return (bf16x8){lo[0], lo[1], lo[2], lo[3], hi[0], hi[1], hi[2], hi[3]};
}

__device__ __forceinline__ unsigned cvt4_fp8(float a, float b, float c, float d) { int w = __builtin_amdgcn_cvt_pk_fp8_f32(a, b, 0, false); w = __builtin_amdgcn_cvt_pk_fp8_f32(c, d, w, true); return (unsigned)w; }
constexpr float W8_SCALE = 64.0f, W8_INV = 1.0f / 64.0f;
#define LDS_WAIT() asm volatile("s_waitcnt lgkmcnt(0)" ::: "memory")
#define VM_WAIT() asm volatile("s_waitcnt vmcnt(0)" ::: "memory")

#define XB_TMO      128
#define XB_XCNT(j)  (256  + 64 * (j))
#define XB_XSUB(j)  (1280 + 64 * (j))
#define XB_XGEN(j)  (2304 + 64 * (j))
#define XB_TOP      3328
#define XB_TOPGEN   3392
#define XCD_BAR_WORDS 3456
#define XB_SPIN_CAP (1u << 18)
__device__ __forceinline__ unsigned xb_ld(unsigned* p)              { return __hip_atomic_load(p, __ATOMIC_RELAXED, __HIP_MEMORY_SCOPE_AGENT); }
__device__ __forceinline__ unsigned xb_add(unsigned* p, unsigned v) { return __hip_atomic_fetch_add(p, v, __ATOMIC_RELAXED, __HIP_MEMORY_SCOPE_AGENT); }
__device__ __forceinline__ unsigned xb_xcc_id() { return (unsigned)__builtin_amdgcn_s_getreg((3 << 11) | 20) & 0xFu; }
#define XB_SPIN(cond, bar) do { unsigned _sp = 0; while (cond) { __builtin_amdgcn_s_sleep(1); \
    if ((++_sp & 255u) == 0u) { if (xb_ld(&(bar)[XB_TMO])) break; if (_sp > XB_SPIN_CAP) { atomicAdd(&(bar)[XB_TMO], 1u); break; } } } } while (0)
struct XcdBarrier { unsigned* bar; unsigned x; volatile LAS unsigned* st; };
__device__ __forceinline__ XcdBarrier xcd_barrier_post(unsigned* bar, volatile LAS unsigned* st) {
    XcdBarrier b; b.bar = bar; b.x = xb_xcc_id(); b.st = st;
    if (threadIdx.x == 0) (void)xb_add(&bar[XB_XCNT(b.x)], 1u);
    return b;
}
__device__ __forceinline__ void xcd_barrier_complete(unsigned* bar, unsigned x, unsigned& nloc, unsigned& nx) {
    const unsigned G = gridDim.x * gridDim.y * gridDim.z;
    unsigned sum, cnt, mine, sp = 0u;
    for (;;) {
        sum = 0u; cnt = 0u; mine = 0u;
#pragma unroll
        for (unsigned j = 0; j < 16; ++j) { const unsigned c = xb_ld(&bar[XB_XCNT(j)]); sum += c; cnt += (c > 0u) ? 1u : 0u; mine = (j == x) ? c : mine; }
        if (sum == G) break;
        __builtin_amdgcn_s_sleep(1);
        if ((++sp & 255u) == 0u) { if (xb_ld(&bar[XB_TMO])) break; if (sp > XB_SPIN_CAP) { atomicAdd(&bar[XB_TMO], 1u); break; } }
    }
    nloc = mine > 0u ? mine : 1u; nx = cnt > 0u ? cnt : 1u;
}
__device__ __forceinline__ void xcd_barrier(const XcdBarrier& b) {
    asm volatile("s_waitcnt vmcnt(0)" ::: "memory");
    __syncthreads();
    if (threadIdx.x == 0) {
        unsigned* bar = b.bar;
        __builtin_amdgcn_s_waitcnt(0);
        unsigned nloc = b.st[0], nx = b.st[1];
        if (nloc == 0u) { xcd_barrier_complete(bar, b.x, nloc, nx); b.st[0] = nloc; b.st[1] = nx; }
        const unsigned old = xb_add(&bar[XB_XSUB(b.x)], 1u);
        const unsigned gen = old / nloc;
        if (old + 1u == (gen + 1u) * nloc) {
            __builtin_amdgcn_fence(__ATOMIC_RELEASE, "agent");
            asm volatile("s_waitcnt vmcnt(0)" ::: "memory");
            const unsigned og = xb_add(&bar[XB_TOP], 1u);
            const unsigned tg = og / nx;
            if (og + 1u == (tg + 1u) * nx) xb_add(&bar[XB_TOPGEN], 1u);
            else XB_SPIN(xb_ld(&bar[XB_TOPGEN]) == tg, bar);
            __builtin_amdgcn_fence(__ATOMIC_ACQUIRE, "agent");
            xb_add(&bar[XB_XGEN(b.x)], 1u);
            asm volatile("s_waitcnt vmcnt(0)" ::: "memory");
        } else {
            XB_SPIN(xb_ld(&bar[XB_XGEN(b.x)]) == gen, bar);
            __builtin_amdgcn_fence(__ATOMIC_ACQUIRE, "agent");
            asm volatile("s_waitcnt vmcnt(0)" ::: "memory");
        }
    }
    __syncthreads();
}

typedef f32x4 Acc[2][2][4][2];
namespace pg8 {
constexpr int BM = 256, BK = 64, HALF = 128, HTB = HALF * BK * 2, NXCD = 8, WGM = 8;
__host__ __device__ __forceinline__ int lds_byte(int r, int c) { const int st = (r >> 4) * 2 + (c >> 5), rr = r & 15, cc = c & 31, ob = rr * 64 + cc * 2; return st * 1024 + (ob ^ (((ob >> 9) & 1) << 5)); }
__host__ __device__ __forceinline__ void stage_rc(int b, int& R, int& C) { const int st = b / 1024, sb = b % 1024, swz = sb ^ (((sb >> 9) & 1) << 5); R = (st >> 1) * 16 + swz / 64; C = (st & 1) * 32 + (swz % 64) / 2; }
__host__ __device__ __forceinline__ int perm32(int rho) { const int n = rho >> 4, i = rho & 15; return 8 * (i >> 2) + 4 * n + (i & 3); }

struct Unit { int pm, pn, e; };
struct Order {
    int nM, nN, nwg, G, c;
    __device__ __forceinline__ void init(int nM_, int nN_, int G_, int c_) { nM = nM_; nN = nN_; nwg = nM * nN; G = G_; c = c_; }
    __device__ __forceinline__ bool idx(int i, int& pm, int& pn) const {
        const long L = (long)i * G + c; if (L >= nwg) return false;
        int wgid = (int)L; { const int q = nwg / NXCD, r = nwg % NXCD, xcd = wgid % NXCD, off = wgid / NXCD; wgid = (xcd < r ? xcd * (q + 1) : r * (q + 1) + (xcd - r) * q) + off; }
        const int nig = WGM * nN, gid = wgid / nig, fm = gid * WGM, gsz = (nM - fm) < WGM ? (nM - fm) : WGM;
        pm = fm + ((wgid % nig) % gsz); pn = (wgid % nig) / gsz; return true;
    }
};

template <class Epi, class Sched>
__device__ __forceinline__ void gemm_phase(LAS unsigned char* lds, const Sched& S, const Epi& E, const int K) {
    const int tid = threadIdx.x, wid = __builtin_amdgcn_readfirstlane(tid >> 6), lane = tid & 63, wr = wid >> 2, wc = wid & 3, fr = lane & 15, fq = lane >> 4;
    constexpr bool I8 = Sched::I8;
    constexpr bool FP8 = Sched::FP8;
    const int nt = (FP8 || I8) ? K / 128 : K / BK; const int pitch = (FP8 || I8) ? K : 2 * K;
    int Rr[2], Cc[2]; unsigned voffA[2], voffB[2];
#pragma unroll
    for (int i = 0; i < 2; ++i) { stage_rc(tid * 16 + i * 8192, Rr[i], Cc[i]); const int Rb = Epi::PERM ? ((Rr[i] & ~31) + perm32(Rr[i] & 31)) : Rr[i];
        voffA[i] = (unsigned)(Rr[i] * pitch + Cc[i] * 2); voffB[i] = (unsigned)(Rb * pitch + Cc[i] * 2); }
    const size_t kstep = (size_t)(BK * 2);
    const size_t hstep = (size_t)HALF * pitch;
    const unsigned ldsw = (unsigned)wid * 1024u;
    const int aoff = lds_byte(wr * 64 + fr, fq * 8), boff = lds_byte(wc * 32 + fr, fq * 8);
#define PG8_SA(b, h) (((b) * 2 + (h)) * HTB)
#define PG8_SB(b, h) ((4 + (b) * 2 + (h)) * HTB)
#define PG8_GLDS(gptr, bufoff, i) __builtin_amdgcn_global_load_lds((const unsigned*)(gptr), (LAS unsigned*)(lds + (bufoff) + ldsw + (i) * 8192), 16, 0, 0)
#define PG8_STAGE_B(bufoff, gbase) do { _Pragma("unroll") for (int _i = 0; _i < 2; ++_i) PG8_GLDS((const char*)(gbase) + voffB[_i], bufoff, _i); } while (0)
#define PG8_STAGE_A(bufoff, TP, AO, h, koff) do { _Pragma("unroll") for (int _i = 0; _i < 2; ++_i) { \
        if constexpr (Sched::GATHER) PG8_GLDS(S.a_base() + (size_t)(koff) + AO[h][_i], bufoff, _i); \
        else PG8_GLDS((TP) + (size_t)(koff) + ((h) ? hstep : (size_t)0) + voffA[_i], bufoff, _i); } } while (0)
#define PG8_LDA(dst, b, h) do { _Pragma("unroll") for (int m = 0; m < 4; ++m) _Pragma("unroll") for (int k = 0; k < 2; ++k) dst[m][k] = *(const LAS bf16x8*)(lds + PG8_SA(b, h) + aoff + m * 2048 + k * 1024); } while (0)
#define PG8_LDB(dst, b, h) do { _Pragma("unroll") for (int n = 0; n < 2; ++n) _Pragma("unroll") for (int k = 0; k < 2; ++k) dst[n][k] = *(const LAS bf16x8*)(lds + PG8_SB(b, h) + boff + n * 2048 + k * 1024); } while (0)
#define PG8_CAT(x) __builtin_shufflevector(__builtin_bit_cast(i32x4, (x)[0]), __builtin_bit_cast(i32x4, (x)[1]), 0, 1, 2, 3, 4, 5, 6, 7)
#define PG8_MMA(ai, bj, At, Bt) do { __builtin_amdgcn_s_setprio(1); _Pragma("unroll") for (int m = 0; m < 4; ++m) _Pragma("unroll") for (int n = 0; n < 2; ++n) { \
        if constexpr (FP8) { const i32x8 _b = PG8_CAT(Bt[n]), _a = PG8_CAT(At[m]);   \
            asm volatile("v_mfma_scale_f32_16x16x128_f8f6f4 %0, %1, %2, %0, %3, %3 op_sel_hi:[0,0,0]" : "+v"(acc[ai][bj][m][n]) : "v"(_b), "v"(_a), "v"(0x7F7F7F7F)); } \
        else if constexpr (I8) { _Pragma("unroll") for (int k = 0; k < 2; ++k) acc[ai][bj][m][n] = __builtin_bit_cast(f32x4, __builtin_amdgcn_mfma_i32_16x16x64_i8(__builtin_bit_cast(i32x4, Bt[n][k]), __builtin_bit_cast(i32x4, At[m][k]), __builtin_bit_cast(i32x4, acc[ai][bj][m][n]), 0, 0, 0)); } \
        else { _Pragma("unroll") for (int k = 0; k < 2; ++k) acc[ai][bj][m][n] = __builtin_amdgcn_mfma_f32_16x16x32_bf16(Bt[n][k], At[m][k], acc[ai][bj][m][n], 0, 0, 0); } } __builtin_amdgcn_s_setprio(0); } while (0)
#define PG8_WAIT_V(n) asm volatile("s_waitcnt vmcnt(" #n ")" ::: "memory")
#define PG8_WAIT_L(n) asm volatile("s_waitcnt lgkmcnt(" #n ")" ::: "memory")
#define PG8_BAR __builtin_amdgcn_s_barrier()
#define PG8_SCHED __builtin_amdgcn_sched_barrier(0)
    Unit cur, nxt; int ui = 0;
    if (!S.next(0, cur)) return;
    f32x4 acc[2][2][4][2];
#pragma unroll
    for (int a = 0; a < 2; ++a)
#pragma unroll
        for (int b = 0; b < 2; ++b)
#pragma unroll
            for (int m = 0; m < 4; ++m)
#pragma unroll
                for (int n = 0; n < 2; ++n) acc[a][b][m][n] = (f32x4){0.f, 0.f, 0.f, 0.f};
    bf16x8 At[4][2], B0[2][2], B1[2][2];
    unsigned aoC[2][2] = {{0u, 0u}, {0u, 0u}}, aoN[2][2] = {{0u, 0u}, {0u, 0u}};
    if constexpr (Sched::GATHER) S.a_offs(0, cur, Rr, Cc, aoC);
    const char* cA = S.a_tile(cur); const char* cB = S.b_tile(cur);
    PG8_STAGE_B(PG8_SB(0, 0), cB); PG8_STAGE_B(PG8_SB(0, 1), cB + hstep); PG8_STAGE_A(PG8_SA(0, 0), cA, aoC, 0, 0); PG8_STAGE_A(PG8_SA(0, 1), cA, aoC, 1, 0);
    if (wr == 1) PG8_BAR;
    PG8_WAIT_V(2); PG8_BAR;
    PG8_STAGE_B(PG8_SB(1, 0), cB + kstep); PG8_STAGE_A(PG8_SA(1, 0), cA, aoC, 0, kstep); PG8_STAGE_B(PG8_SB(1, 1), cB + hstep + kstep);
    PG8_WAIT_V(6); PG8_BAR;
    for (;;) {
        const bool has_next = S.next(ui + 1, nxt);
        const char* nA = has_next ? S.a_tile(nxt) : cA; const char* nB = has_next ? S.b_tile(nxt) : cB;
        if constexpr (Sched::GATHER) { if (has_next) S.a_offs(ui + 1, nxt, Rr, Cc, aoN); else {
#pragma unroll
            for (int h = 0; h < 2; ++h)
#pragma unroll
                for (int i = 0; i < 2; ++i) aoN[h][i] = aoC[h][i]; } }
        constexpr int NSEG = Epi::MIDK ? 2 : 1;
#pragma unroll 1
        for (int seg = 0; seg < NSEG; ++seg) {
        if constexpr (Epi::MIDK) { if (seg == 1) { Acc& accr = acc; E.midk(accr, cur, wr, wc, fr, fq); } }
#pragma unroll 1
        for (int t = seg * (nt / NSEG); t < (seg + 1) * (nt / NSEG); t += 2) {
            const bool last = (t == nt - 2);
            const size_t k1 = (size_t)(t + 1) * kstep;
            const size_t k2 = last ? (size_t)0 : (size_t)(t + 2) * kstep, k3 = k2 + kstep;
            const char* a2 = last ? nA : cA; const char* b2 = last ? nB : cB + (size_t)(t + 2) * kstep; const char* b3 = b2 + kstep;
            unsigned ax[2][2];
#pragma unroll
            for (int h = 0; h < 2; ++h)
#pragma unroll
                for (int i = 0; i < 2; ++i) ax[h][i] = last ? aoN[h][i] : aoC[h][i];
            PG8_LDB(B0, 0, 0); PG8_LDB(B1, 0, 1); PG8_SCHED; PG8_LDA(At, 0, 0); PG8_STAGE_A(PG8_SA(1, 1), cA, aoC, 1, k1);
            PG8_WAIT_V(8); PG8_WAIT_L(0); PG8_BAR; PG8_MMA(0, 0, At, B0); PG8_MMA(0, 1, At, B1); PG8_BAR; PG8_SCHED;
            PG8_LDA(At, 0, 1); PG8_STAGE_B(PG8_SB(0, 0), b2); PG8_STAGE_B(PG8_SB(0, 1), b2 + hstep); PG8_STAGE_A(PG8_SA(0, 0), a2, ax, 0, k2);
            PG8_WAIT_V(8); PG8_WAIT_L(0); PG8_BAR; PG8_MMA(1, 0, At, B0); PG8_MMA(1, 1, At, B1); PG8_BAR; PG8_SCHED;
            PG8_LDB(B0, 1, 0); PG8_LDB(B1, 1, 1); PG8_SCHED; PG8_LDA(At, 1, 0); PG8_STAGE_A(PG8_SA(0, 1), a2, ax, 1, k2);
            PG8_WAIT_V(8); PG8_WAIT_L(0); PG8_BAR; PG8_MMA(0, 0, At, B0); PG8_MMA(0, 1, At, B1); PG8_BAR; PG8_SCHED;
            PG8_LDA(At, 1, 1); PG8_STAGE_B(PG8_SB(1, 0), b3); PG8_STAGE_B(PG8_SB(1, 1), b3 + hstep); PG8_STAGE_A(PG8_SA(1, 0), a2, ax, 0, k3);
            PG8_WAIT_V(8); PG8_WAIT_L(0); PG8_BAR; PG8_MMA(1, 0, At, B0); PG8_MMA(1, 1, At, B1); PG8_BAR; PG8_SCHED;
        }
        }
        if (wr == 0) PG8_BAR;
        E(acc, cur, ui, wr, wc, fr, fq);
        if (!has_next) break;
#pragma unroll
        for (int a = 0; a < 2; ++a)
#pragma unroll
            for (int b = 0; b < 2; ++b)
#pragma unroll
                for (int m = 0; m < 4; ++m)
#pragma unroll
                    for (int n = 0; n < 2; ++n) acc[a][b][m][n] = (f32x4){0.f, 0.f, 0.f, 0.f};
        cur = nxt; cA = nA; cB = nB; ++ui;
#pragma unroll
        for (int h = 0; h < 2; ++h)
#pragma unroll
            for (int i = 0; i < 2; ++i) aoC[h][i] = aoN[h][i];
        if (wr == 1) PG8_BAR;
    }
    PG8_WAIT_V(0);
    PG8_BAR;
#undef PG8_SA
#undef PG8_SB
#undef PG8_GLDS
#undef PG8_STAGE_A
#undef PG8_STAGE_B
#undef PG8_LDA
#undef PG8_LDB
#undef PG8_MMA
#undef PG8_CAT
#undef PG8_WAIT_V
#undef PG8_WAIT_L
#undef PG8_BAR
#undef PG8_SCHED
}
}
using pg8::Unit;

struct Params { const float* in[26]; float* out; unsigned char* ws; int ph_lo, ph_hi, li, pad; };
enum { I_X = 0, I_C, I_ADAW, I_ADAB, I_N1G, I_WIN, I_GW2, I_GGB, I_LNG, I_LNB, I_SGW, I_SGB, I_GNG, I_WA, I_WB, I_WOUT, I_N2G, I_RW, I_RB, I_EWG, I_EBG, I_EWU, I_EBU, I_EWD, I_EBD, I_FG };
#define WSP(T, off) ((T*)(p.ws + (off)))

struct DenseSched8 {
    static constexpr bool GATHER = false, FP8 = false, I8 = true;
    pg8::Order o; const char* A; const char* Bt; int K, pn0;
    __device__ __forceinline__ bool next(int i, Unit& u) const { u.e = 0; if (!o.idx(i, u.pm, u.pn)) return false; u.pn += pn0; return true; }
    __device__ __forceinline__ const char* a_base() const { return A; }
    __device__ __forceinline__ const char* a_tile(const Unit& u) const { return A + (size_t)u.pm * 256 * K; }
    __device__ __forceinline__ const char* b_tile(const Unit& u) const { return Bt + (size_t)(u.pn - pn0) * 256 * K; }
    __device__ __forceinline__ void a_offs(int, const Unit&, const int (&)[2], const int (&)[2], unsigned (&)[2][2]) const {}
};
template <bool F8> struct DenseSchedT {
    static constexpr bool GATHER = false, FP8 = F8, I8 = false; static constexpr int ES = F8 ? 1 : 2;
    pg8::Order o; const char* A; const char* Bt; int K;
    __device__ __forceinline__ bool next(int i, Unit& u) const { u.e = 0; return o.idx(i, u.pm, u.pn); }
    __device__ __forceinline__ const char* a_base() const { return A; }
    __device__ __forceinline__ const char* a_tile(const Unit& u) const { return A + (size_t)u.pm * 256 * K * ES; }
    __device__ __forceinline__ const char* b_tile(const Unit& u) const { return Bt + (size_t)u.pn * 256 * K * ES; }
    __device__ __forceinline__ void a_offs(int, const Unit&, const int (&)[2], const int (&)[2], unsigned (&)[2][2]) const {}
};
typedef DenseSchedT<false> DenseSched; typedef DenseSchedT<(MIX8 & 1) != 0> SchedM; typedef DenseSchedT<(MIX8 & 4) != 0> SchedO;
constexpr float MIXSM = (MIX8 & 1) ? W8_INV : 1.0f;
constexpr float MIXSO = (MIX8 & 4) ? W8_INV : 1.0f;
struct Moe1Sched {
    static constexpr bool GATHER = true, FP8 = true, I8 = false;
    pg8::Order o; const char* A; const char* W; const LAS int* tab; const LAS unsigned* goff;
    __device__ __forceinline__ bool next(int i, Unit& u) const { if (!o.idx(i, u.pm, u.pn)) return false; u.e = __builtin_amdgcn_readfirstlane(tab[72 + u.pm]); return true; }
    __device__ __forceinline__ const char* a_base() const { return A; }
    __device__ __forceinline__ const char* a_tile(const Unit&) const { return A; }
    __device__ __forceinline__ const char* b_tile(const Unit& u) const { return W + ((size_t)u.e * 4096 + (size_t)u.pn * 256) * 2048; }
    __device__ __forceinline__ void a_offs(int i, const Unit&, const int (&R)[2], const int (&C)[2], unsigned (&ao)[2][2]) const {
#pragma unroll
        for (int h = 0; h < 2; ++h)
#pragma unroll
            for (int j = 0; j < 2; ++j) ao[h][j] = goff[i * 256 + h * 128 + R[j]] + (unsigned)C[j] * 2u;
    }
};
struct Moe2Sched {
    static constexpr bool GATHER = false, FP8 = true, I8 = false;
    pg8::Order o; const char* A; const char* W; const LAS int* tab;
    __device__ __forceinline__ bool next(int i, Unit& u) const { if (!o.idx(i, u.pm, u.pn)) return false; u.e = __builtin_amdgcn_readfirstlane(tab[72 + u.pm]); return true; }
    __device__ __forceinline__ const char* a_base() const { return A; }
    __device__ __forceinline__ const char* a_tile(const Unit& u) const { return A + (size_t)u.pm * 256 * 2048; }
    __device__ __forceinline__ const char* b_tile(const Unit& u) const { return W + ((size_t)u.e * 2048 + (size_t)u.pn * 256) * 2048; }
    __device__ __forceinline__ void a_offs(int, const Unit&, const int (&)[2], const int (&)[2], unsigned (&)[2][2]) const {}
};

__device__ __forceinline__ u32x4 pack8(const f32x4 v0, const f32x4 v1) { u32x4 w; w.x = cvt_pk_bf16(v0[0], v0[1]); w.y = cvt_pk_bf16(v0[2], v0[3]); w.z = cvt_pk_bf16(v1[0], v1[1]); w.w = cvt_pk_bf16(v1[2], v1[3]); return w; }
template <int ACT> __device__ __forceinline__ float act_f(float x) {
    if (ACT == 1) return gelu_tanh(x);
    if (ACT == 2) return x * fast_sigmoid(x);
    if (ACT == 3) return fast_sigmoid(x);
    return x;
}
struct EpiProj {
    static constexpr bool PERM = true, MIDK = false;
    unsigned char* ws; bool i8;
    __device__ __forceinline__ void operator()(const Acc& acc, const Unit& u, int, int wr, int wc, int fr, int fq) const {
        const int pn = u.pn, row0 = u.pm * 256 + wr * 64 + fr, cw = wc * 32 + 8 * fq;
        int act, ldc = 2048, pl; size_t boff;
        if (pn < 8)       { act = 1; boff = WS_AU; pl = pn; }
        else if (pn < 16) { act = 1; boff = WS_AV; pl = pn - 8; }
        else if (pn < 20) { act = 0; boff = WS_Q; pl = pn - 16; ldc = 1024; }
        else if (pn < 24) { act = 0; boff = WS_K; pl = pn - 20; ldc = 1024; }
        else if (pn < 32) { act = 0; boff = WS_V; pl = pn - 24; }
        else if (pn < 40) { act = 2; boff = WS_R; pl = pn - 32; }
        else if (pn < 48) { act = 3; boff = WS_GA; pl = pn - 40; }
        else              { act = 3; boff = WS_GB; pl = pn - 48; }
        const bool lns = (pn >= 8 && pn < 16);
        bf16_t* base = (bf16_t*)(ws + boff); const int col0 = pl * 256 + cw;
        float* lnp = (float*)(ws + WS_LNP) + (pl * 4 + wc) * 2;
        f32x4 wsc[2][2];
#pragma unroll
        for (int bj = 0; bj < 2; ++bj) { const float* wp = (const float*)(ws + WS_WS) + pn * 256 + bj * 128 + cw; wsc[bj][0] = i8 ? *(const f32x4*)wp : (f32x4){1.f, 1.f, 1.f, 1.f}; wsc[bj][1] = i8 ? *(const f32x4*)(wp + 4) : (f32x4){1.f, 1.f, 1.f, 1.f}; }
        float hsv[2][4];
#pragma unroll
        for (int ai = 0; ai < 2; ++ai)
#pragma unroll
            for (int m = 0; m < 4; ++m) hsv[ai][m] = i8 ? ((const float*)(ws + WS_HS))[row0 + ai * 128 + m * 16] : 1.0f;
        if (act == 0) {
#pragma unroll
            for (int ai = 0; ai < 2; ++ai)
#pragma unroll
                for (int m = 0; m < 4; ++m) { const int row = row0 + ai * 128 + m * 16; bf16_t* rowp = base + (size_t)row * ldc + col0; const float hs = hsv[ai][m];
#pragma unroll
                    for (int bj = 0; bj < 2; ++bj) { f32x4 v[2] = {acc[ai][bj][m][0], acc[ai][bj][m][1]};
                        if (i8) {
#pragma unroll
                            for (int j = 0; j < 4; ++j) { v[0][j] = (float)__float_as_int(v[0][j]) * (hs * wsc[bj][0][j]); v[1][j] = (float)__float_as_int(v[1][j]) * (hs * wsc[bj][1][j]); } }
                        __builtin_nontemporal_store(pack8(v[0], v[1]), (u32x4*)(rowp + bj * 128)); }
                    asm volatile("" ::: "memory"); }
            return;
        }
#pragma unroll
        for (int ai = 0; ai < 2; ++ai)
#pragma unroll
            for (int m = 0; m < 4; ++m) { const int row = row0 + ai * 128 + m * 16; bf16_t* rowp = base + (size_t)row * ldc + col0; float s = 0.f, q = 0.f;
                const float hs = hsv[ai][m];
#pragma unroll
                for (int bj = 0; bj < 2; ++bj) { f32x4 v[2] = {acc[ai][bj][m][0], acc[ai][bj][m][1]};
                    if (i8) {
#pragma unroll
                        for (int j = 0; j < 4; ++j) { v[0][j] = (float)__float_as_int(v[0][j]) * (hs * wsc[bj][0][j]); v[1][j] = (float)__float_as_int(v[1][j]) * (hs * wsc[bj][1][j]); } }
#pragma unroll
                    for (int h = 0; h < 2; ++h)
#pragma unroll
                        for (int j = 0; j < 4; ++j) { const float x = v[h][j]; const float t = (act == 1) ? 1.5957691216f * (x + 0.044715f * x * x * x) : x;
                            const float sg = fast_sigmoid(t); v[h][j] = (act == 3) ? sg : x * sg; }
                    if (lns) {
#pragma unroll
                        for (int h = 0; h < 2; ++h)
#pragma unroll
                            for (int j = 0; j < 4; ++j) { s += v[h][j]; q += v[h][j] * v[h][j]; } }
                    __builtin_nontemporal_store(pack8(v[0], v[1]), (u32x4*)(rowp + bj * 128)); }
                if (lns) { s += __shfl_xor(s, 16); s += __shfl_xor(s, 32); q += __shfl_xor(q, 16); q += __shfl_xor(q, 32);
                    if ((threadIdx.x & 63) < 16) *(f32x2*)(lnp + (size_t)row * 64) = (f32x2){s, q}; }
                asm volatile("" ::: "memory"); }
    }
};
struct EpiMerge {
    static constexpr bool PERM = true, MIDK = true;
    const bf16_t* GA; const bf16_t* GB; bf16_t* O;
    __device__ __forceinline__ void midk(Acc& acc, const Unit& u, int wr, int wc, int fr, int fq) const {
        const size_t off0 = (size_t)(u.pm * 256 + wr * 64 + fr) * 2048 + u.pn * 256 + wc * 32 + 8 * fq;
        const bf16_t* pa = GA + off0; const bf16_t* pb = GB + off0;
#pragma unroll
        for (int ai = 0; ai < 2; ++ai) {
#pragma unroll
            for (int m = 0; m < 4; ++m) {
#pragma unroll
                for (int bj = 0; bj < 2; ++bj) { const u32x4 a = *(const u32x4*)(pa + bj * 128), b = *(const u32x4*)(pb + bj * 128);
                    const unsigned aw[4] = {a.x, a.y, a.z, a.w}, bw[4] = {b.x, b.y, b.z, b.w};
#pragma unroll
                    for (int j = 0; j < 4; ++j) { const float r0 = bflo(aw[j]) * __builtin_amdgcn_rcpf(fmaxf(bflo(bw[j]), 1e-30f)), r1 = bfhi(aw[j]) * __builtin_amdgcn_rcpf(fmaxf(bfhi(bw[j]), 1e-30f));
                        acc[ai][bj][m][j >> 1][2 * (j & 1)] *= r0; acc[ai][bj][m][j >> 1][2 * (j & 1) + 1] *= r1; } }
                pa += 16 * 2048; pb += 16 * 2048; asm volatile("" : "+v"(pa), "+v"(pb) :: "memory"); }
            pa += 64 * 2048; pb += 64 * 2048; asm volatile("" : "+v"(pa), "+v"(pb)); }
    }
    __device__ __forceinline__ void operator()(const Acc& acc, const Unit& u, int, int wr, int wc, int fr, int fq) const {
        const int row0 = u.pm * 256 + wr * 64 + fr, col0 = u.pn * 256 + wc * 32 + 8 * fq;
#pragma unroll
        for (int ai = 0; ai < 2; ++ai)
#pragma unroll
            for (int m = 0; m < 4; ++m) { const size_t off = (size_t)(row0 + ai * 128 + m * 16) * 2048 + col0;
#pragma unroll
                for (int bj = 0; bj < 2; ++bj) { const u32x4 g = *(const u32x4*)(GB + off + bj * 128);
                    f32x4 o0 = acc[ai][bj][m][0] * MIXSM, o1 = acc[ai][bj][m][1] * MIXSM;
                    o0[0] *= bflo(g.x); o0[1] *= bfhi(g.x); o0[2] *= bflo(g.y); o0[3] *= bfhi(g.y); o1[0] *= bflo(g.z); o1[1] *= bfhi(g.z); o1[2] *= bflo(g.w); o1[3] *= bfhi(g.w);
                    if (MIX8 & 4) { u32x2 w8; w8.x = cvt4_fp8(o0[0], o0[1], o0[2], o0[3]); w8.y = cvt4_fp8(o1[0], o1[1], o1[2], o1[3]); *(u32x2*)((unsigned char*)O + off + bj * 128) = w8; }
                    else *(u32x4*)(O + off + bj * 128) = pack8(o0, o1); } }
    }
};
struct EpiOut {
    static constexpr bool PERM = true, MIDK = false;
    const float* X; const float* MOD; float* X1;
    __device__ __forceinline__ void operator()(const Acc& acc, const Unit& u, int, int wr, int wc, int fr, int fq) const {
        const int row0 = u.pm * 256 + wr * 64 + fr, col0 = u.pn * 256 + wc * 32 + 8 * fq;
        const float* gt = MOD + (size_t)((u.pm * 256) >> 11) * 12288 + 2 * 2048 + col0;
        f32x4 g[2][2];
#pragma unroll
        for (int bj = 0; bj < 2; ++bj) { g[bj][0] = *(const f32x4*)(gt + bj * 128); g[bj][1] = *(const f32x4*)(gt + bj * 128 + 4); }
#pragma unroll
        for (int ai = 0; ai < 2; ++ai)
#pragma unroll
            for (int m = 0; m < 4; ++m) { const size_t off = (size_t)(row0 + ai * 128 + m * 16) * 2048 + col0;
#pragma unroll
                for (int bj = 0; bj < 2; ++bj) { const f32x4 x0 = *(const f32x4*)(X + off + bj * 128), x1 = *(const f32x4*)(X + off + bj * 128 + 4);
                    *(f32x4*)(X1 + off + bj * 128) = x0 + g[bj][0] * (acc[ai][bj][m][0] * MIXSO); *(f32x4*)(X1 + off + bj * 128 + 4) = x1 + g[bj][1] * (acc[ai][bj][m][1] * MIXSO); } }
    }
};
struct EpiAct {
    static constexpr bool PERM = true, MIDK = false;
    const float* bg; const float* bu; bf16_t* ACT;
    __device__ __forceinline__ void operator()(const Acc& acc, const Unit& u, int, int wr, int wc, int fr, int fq) const {
        const int row0 = u.pm * 256 + wr * 64 + fr, col0 = u.pn * 128 + wc * 32 + 8 * fq;
        const f32x4 g0 = *(const f32x4*)(bg + (size_t)u.e * 2048 + col0), g1 = *(const f32x4*)(bg + (size_t)u.e * 2048 + col0 + 4);
        const f32x4 u0 = *(const f32x4*)(bu + (size_t)u.e * 2048 + col0), u1 = *(const f32x4*)(bu + (size_t)u.e * 2048 + col0 + 4);
#pragma unroll
        for (int ai = 0; ai < 2; ++ai)
#pragma unroll
            for (int m = 0; m < 4; ++m) { f32x4 o0, o1;
#pragma unroll
                for (int j = 0; j < 4; ++j) {
                    float g = fminf(acc[ai][0][m][0][j] * W8_INV + g0[j], 7.0f), up = fminf(fmaxf(acc[ai][1][m][0][j] * W8_INV + u0[j], -7.0f), 7.0f); o0[j] = (up + 1.0f) * (g * fast_sigmoid(1.702f * g));
                    g = fminf(acc[ai][0][m][1][j] * W8_INV + g1[j], 7.0f); up = fminf(fmaxf(acc[ai][1][m][1][j] * W8_INV + u1[j], -7.0f), 7.0f); o1[j] = (up + 1.0f) * (g * fast_sigmoid(1.702f * g)); }
                u32x2 w; w.x = cvt4_fp8(o0[0], o0[1], o0[2], o0[3]); w.y = cvt4_fp8(o1[0], o1[1], o1[2], o1[3]);
                *(u32x2*)((unsigned char*)ACT + (size_t)(row0 + ai * 128 + m * 16) * 2048 + col0) = w; }
    }
};
struct EpiDown {
    static constexpr bool PERM = true, MIDK = false;
    const float* bd; bf16_t* Y; const int* LIST; const LAS int* tab;
    __device__ __forceinline__ void operator()(const Acc& acc, const Unit& u, int, int wr, int wc, int fr, int fq) const {
        const int e = u.e, rt = u.pm - tab[32 + e], cnt = tab[e];
        const int col0 = u.pn * 256 + wc * 32 + 8 * fq;
        f32x4 b[2][2];
#pragma unroll
        for (int bj = 0; bj < 2; ++bj) { b[bj][0] = *(const f32x4*)(bd + (size_t)e * 2048 + col0 + bj * 128); b[bj][1] = *(const f32x4*)(bd + (size_t)e * 2048 + col0 + bj * 128 + 4); }
        int slots[2][4];
#pragma unroll
        for (int ai = 0; ai < 2; ++ai)
#pragma unroll
            for (int m = 0; m < 4; ++m) slots[ai][m] = LIST[e * 8192 + ((rt * 256 + ai * 128 + wr * 64 + m * 16 + fr) & 8191)];
#pragma unroll
        for (int ai = 0; ai < 2; ++ai)
#pragma unroll
            for (int m = 0; m < 4; ++m) { const int pos = rt * 256 + ai * 128 + wr * 64 + m * 16 + fr;
                if (pos < cnt) { const int slot = slots[ai][m]; bf16_t* rowp = Y + (size_t)slot * 2048 + col0;
#pragma unroll
                    for (int bj = 0; bj < 2; ++bj) *(u32x4*)(rowp + bj * 128) = pack8(acc[ai][bj][m][0] * W8_INV + b[bj][0], acc[ai][bj][m][1] * W8_INV + b[bj][1]); } }
    }
};

constexpr int NWAVES = 8;
template <bool F8> __device__ __forceinline__ void p0_transpose_item(const float* W, int ld, void* WT, int k0, int n0src, int rowdst, int lane, int dpitch = 2048, int dk0 = 0, LAS unsigned char* scr = nullptr) {
    const int n = lane & 31, h = lane >> 5; const float* src = W + (size_t)(k0 + 64 * h) * ld + n0src + n;
    float v[64];
#pragma unroll
    for (int i = 0; i < 64; ++i) v[i] = __builtin_nontemporal_load(src + (size_t)i * ld);
    if constexpr (F8) {
        if (scr) {
#pragma unroll
            for (int j = 0; j < 4; ++j) { u32x4 o;
#pragma unroll
                for (int q = 0; q < 4; ++q) o[q] = cvt4_fp8(v[16 * j + 4 * q] * W8_SCALE, v[16 * j + 4 * q + 1] * W8_SCALE, v[16 * j + 4 * q + 2] * W8_SCALE, v[16 * j + 4 * q + 3] * W8_SCALE);
                *(LAS u32x4*)(scr + (n * 9 + 4 * h + j) * 16) = o; }
            LDS_WAIT(); asm volatile("" ::: "memory");
#pragma unroll
            for (int j = 0; j < 4; ++j) { const int row = (lane >> 3) + 8 * j, pc = lane & 7; const u32x4 o = *(const LAS u32x4*)(scr + (row * 9 + pc) * 16);
                __builtin_nontemporal_store(o, (u32x4*)((unsigned char*)WT + (size_t)(rowdst + row) * dpitch + dk0 + k0 + 16 * pc)); }
            LDS_WAIT(); asm volatile("" ::: "memory");
        } else { unsigned char* dst = (unsigned char*)WT + (size_t)(rowdst + n) * dpitch + dk0 + k0 + 64 * h;
#pragma unroll
        for (int j = 0; j < 4; ++j) { u32x4 o;
#pragma unroll
            for (int q = 0; q < 4; ++q) o[q] = cvt4_fp8(v[16 * j + 4 * q] * W8_SCALE, v[16 * j + 4 * q + 1] * W8_SCALE, v[16 * j + 4 * q + 2] * W8_SCALE, v[16 * j + 4 * q + 3] * W8_SCALE);
            *(u32x4*)(dst + 16 * j) = o; } }
    } else { bf16_t* dst = (bf16_t*)WT + (size_t)(rowdst + n) * dpitch + dk0 + k0 + 64 * h;
#pragma unroll
        for (int j = 0; j < 8; ++j) { u32x4 o;
#pragma unroll
            for (int q = 0; q < 4; ++q) o[q] = cvt_pk_bf16(v[8 * j + 2 * q], v[8 * j + 2 * q + 1]);
            *(u32x4*)(dst + 8 * j) = o; } }
}
constexpr int DSPLIT_E0 = 4, DSPLIT_E1 = 12, DSPLIT_ITEMS = (DSPLIT_E1 - DSPLIT_E0) * 1024;
constexpr int XSPLIT = 128 * 8 * 12;
__device__ __forceinline__ void p0_expert_item(const Params& p, LAS unsigned char* scr, int r, int lane) {
    constexpr int IT_SQ = 16 * 64;
    const int e = r / (3 * IT_SQ), q3 = r % (3 * IT_SQ), which = q3 / IT_SQ, q = q3 % IT_SQ, kb = q >> 6, nb = q & 63, n0 = 32 * nb;
    if (which < 2) p0_transpose_item<true>(p.in[which == 0 ? I_EWG : I_EWU] + (size_t)e * 2048 * 2048, 2048, WSP(unsigned char, WS_WGU_T) + (size_t)e * 4096 * 2048, 128 * kb, n0, (n0 >> 7) * 256 + (n0 & 127) + which * 128, lane, 2048, 0, scr);
    else p0_transpose_item<true>(p.in[I_EWD] + (size_t)e * 2048 * 2048, 2048, WSP(unsigned char, WS_WDN_T) + (size_t)e * 2048 * 2048, 128 * kb, n0, n0, lane, 2048, 0, scr);
}
__device__ __forceinline__ void xp_load(const Params& p, float (&v)[64], int r, int lane) {
    constexpr int IT_SQ = 16 * 64;
    const int e = r / (3 * IT_SQ), q3 = r % (3 * IT_SQ), which = q3 / IT_SQ, q = q3 % IT_SQ, kb = q >> 6, nb = q & 63;
    const float* W = p.in[which == 0 ? I_EWG : which == 1 ? I_EWU : I_EWD] + (size_t)e * 2048 * 2048;
    const int n = lane & 31, h = lane >> 5; const float* src = W + (size_t)(128 * kb + 64 * h) * 2048 + 32 * nb + n;
#pragma unroll
    for (int i = 0; i < 64; ++i) v[i] = __builtin_nontemporal_load(src + (size_t)i * 2048);
}
__device__ __forceinline__ void xp_store(const Params& p, const float (&v)[64], int r, int lane, LAS unsigned char* scr) {
    constexpr int IT_SQ = 16 * 64;
    const int e = r / (3 * IT_SQ), q3 = r % (3 * IT_SQ), which = q3 / IT_SQ, q = q3 % IT_SQ, kb = q >> 6, nb = q & 63, n0 = 32 * nb;
    unsigned char* WT = which < 2 ? WSP(unsigned char, WS_WGU_T) + (size_t)e * 4096 * 2048 : WSP(unsigned char, WS_WDN_T) + (size_t)e * 2048 * 2048;
    const int rowdst = which < 2 ? (n0 >> 7) * 256 + (n0 & 127) + which * 128 : n0, n = lane & 31, h = lane >> 5;
#pragma unroll
    for (int j = 0; j < 4; ++j) { u32x4 o;
#pragma unroll
        for (int q4 = 0; q4 < 4; ++q4) o[q4] = cvt4_fp8(v[16 * j + 4 * q4] * W8_SCALE, v[16 * j + 4 * q4 + 1] * W8_SCALE, v[16 * j + 4 * q4 + 2] * W8_SCALE, v[16 * j + 4 * q4 + 3] * W8_SCALE);
        *(LAS u32x4*)(scr + (n * 9 + 4 * h + j) * 16) = o; }
    LDS_WAIT(); asm volatile("" ::: "memory");
#pragma unroll
    for (int j = 0; j < 4; ++j) { const int row = (lane >> 3) + 8 * j, pc = lane & 7; const u32x4 o = *(const LAS u32x4*)(scr + (row * 9 + pc) * 16);
        __builtin_nontemporal_store(o, (u32x4*)(WT + (size_t)(rowdst + row) * 2048 + 128 * kb + 16 * pc)); }
    LDS_WAIT(); asm volatile("" ::: "memory");
}
template <bool DN> __device__ __forceinline__ void xp_run(const Params& p, LAS unsigned char* scr, int base, int stride, int n, int lane) {
    auto item = [&](int i) { const int x = base + stride * i; return DN ? (DSPLIT_E0 + (x >> 10)) * 3072 + 2048 + (x & 1023) : x; };
    float va[64], vb[64];
    if (n > 0) xp_load(p, va, item(0), lane);
    for (int i = 0; i < n; i += 2) {
        if (i + 1 < n) xp_load(p, vb, item(i + 1), lane);
        xp_store(p, va, item(i), lane, scr);
        if (i + 2 < n) xp_load(p, va, item(i + 2), lane);
        if (i + 1 < n) xp_store(p, vb, item(i + 1), lane, scr);
    }
}
__device__ __forceinline__ void p0_prologue(const Params& p, LAS unsigned char* lds) {
    const int tid = threadIdx.x, lane = tid & 63, wave = __builtin_amdgcn_readfirstlane(tid >> 6), G = gridDim.x;
    if ((int)blockIdx.x < 192) {
        LAS float* sc = (LAS float*)lds; LAS float* red = (LAS float*)(lds + 32768);
        for (int i = tid; i < 4 * 2048; i += 512) { const float c = p.in[I_C][i]; sc[i] = c / (1.0f + expf(-c)); }
        __syncthreads();
        for (int item = blockIdx.x; item < 192; item += G) {
            const int cl = tid & 15, rg = tid >> 4; const float* w = p.in[I_ADAW] + item * 64 + 4 * cl;
            f32x4 a[4];
#pragma unroll
            for (int b = 0; b < 4; ++b) a[b] = (f32x4){0.f, 0.f, 0.f, 0.f};
#pragma unroll 32
            for (int i = 0; i < 64; ++i) { const int k = rg + 32 * i; const f32x4 wv = *(const f32x4*)(w + (size_t)k * 12288);
#pragma unroll
                for (int b = 0; b < 4; ++b) a[b] += wv * sc[b * 2048 + k]; }
#pragma unroll
            for (int b = 0; b < 4; ++b) *(LAS f32x4*)(red + (rg * 4 + b) * 64 + 4 * cl) = a[b];
            __syncthreads();
            if (tid < 256) { const int b = tid >> 6, col = tid & 63; float s = 0.f;
#pragma unroll 8
                for (int r = 0; r < 32; ++r) s += red[(r * 4 + b) * 64 + col];
                WSP(float, WS_MOD)[b * 12288 + item * 64 + col] = s + p.in[I_ADAB][item * 64 + col]; }
            __syncthreads();
        }
    }
    for (int i = blockIdx.x * 512 + tid; i < 16 * 2048; i += G * 512) { const int j = i >> 11, k = i & 2047; WSP(bf16_t, WS_WG_T)[i] = (bf16_t)(cvt_pk_bf16(p.in[I_WIN][(size_t)k * INW + 10240 + j], 0.f) & 0xffffu); }
    const int gw = blockIdx.x * NWAVES + wave, NGW = G * NWAVES;
    constexpr int IT_WIN = 16 * 448, IT_SQ = 16 * 64, IT_B = 3 * IT_SQ, IT_E = 32 * 3 * IT_SQ, NITEMS = IT_WIN + IT_B + IT_E;
    for (int it0 = gw; it0 < NITEMS; it0 += NGW) {
        int r = NITEMS - 1 - it0;
        if (r < IT_WIN) { const int kb = r / 448, nb = r % 448, n0 = 32 * nb; if (n0 < PROJ8_PN0 * 256) p0_transpose_item<false>(p.in[I_WIN], INW, WSP(bf16_t, WS_WIN_T), 128 * kb, n0 + (n0 >= 10240 ? 16 : 0), n0, lane);
            else p0_transpose_item<false>(p.in[I_WIN], INW, WSP(bf16_t, WS_WIN_T), 128 * kb, n0 + (n0 >= 10240 ? 16 : 0), n0, lane);
            continue; }
        r -= IT_WIN;
        if (r < IT_B) { const int which = r / IT_SQ, q = r % IT_SQ, kb = q >> 6, nb = q & 63;
            if (which < 2) { if (MIX8 & 1) p0_transpose_item<true>(p.in[I_WA + which], 2048, WSP(unsigned char, WS_WA_T), 128 * kb, 32 * nb, 32 * nb, lane, 4096, 2048 * which); else p0_transpose_item<false>(p.in[I_WA + which], 2048, WSP(bf16_t, WS_WA_T), 128 * kb, 32 * nb, 32 * nb, lane, 4096, 2048 * which); }
            else if (MIX8 & 4) p0_transpose_item<true>(p.in[I_WOUT], 2048, WSP(unsigned char, WS_WOUT_T), 128 * kb, 32 * nb, 32 * nb, lane);
            else p0_transpose_item<false>(p.in[I_WOUT], 2048, WSP(bf16_t, WS_WOUT_T), 128 * kb, 32 * nb, 32 * nb, lane);
            continue; }
        r -= IT_B;
        if (G == 256 && r < XSPLIT) continue;
        if (G == 256 && (r / IT_SQ) % 3 == 2 && r / (3 * IT_SQ) >= DSPLIT_E0 && r / (3 * IT_SQ) < DSPLIT_E1) continue;
        p0_expert_item(p, lds + 65536 + wave * 8192, r, lane);
    }
}
__device__ __forceinline__ void p1_norm1(const Params& p) {
    const int tid = threadIdx.x, lane = tid & 63, wave = tid >> 6, G = gridDim.x, gw = blockIdx.x * NWAVES + wave, NGW = G * NWAVES;
    const float* MOD = WSP(float, WS_MOD);
    const int rpw = (NTOK + NGW - 1) / NGW; f32x4 gq[8], scq[8], shq[8]; int bprev = -1;
#pragma unroll
    for (int j = 0; j < 8; ++j) gq[j] = *(const f32x4*)(p.in[I_N1G] + 4 * lane + 256 * j);
    for (int ir = 0; ir < rpw; ++ir) { const int m = gw * rpw + ir; if (m >= NTOK) break;
        const int b = m >> 11; const float* xr = p.in[I_X] + (size_t)m * 2048; f32x4 v[8]; float s = 0.f;
        if (b != bprev) { bprev = b;
#pragma unroll
            for (int j = 0; j < 8; ++j) { scq[j] = *(const f32x4*)(MOD + b * 12288 + 2048 + 4 * lane + 256 * j); shq[j] = *(const f32x4*)(MOD + b * 12288 + 4 * lane + 256 * j); } }
#pragma unroll
        for (int j = 0; j < 8; ++j) { v[j] = *(const f32x4*)(xr + 4 * lane + 256 * j); s += (v[j][0] * v[j][0] + v[j][1] * v[j][1]) + (v[j][2] * v[j][2] + v[j][3] * v[j][3]); }
        const float rstd = rsqrtf(wave_sum(s) * (1.0f / 2048.0f) + EPS);
        bf16_t* hr = WSP(bf16_t, WS_H) + (size_t)m * 2048; float amax = 0.f;
#pragma unroll
        for (int j = 0; j < 8; ++j) { const int c = 4 * lane + 256 * j; const f32x4 g = gq[j], sc = scq[j], sh = shq[j];
            const f32x4 o = v[j] * rstd * g * (sc + 1.0f) + sh; u32x2 w; w.x = cvt_pk_bf16(o[0], o[1]); w.y = cvt_pk_bf16(o[2], o[3]); *(u32x2*)(hr + c) = w;
            v[j] = o; amax = fmaxf(fmaxf(amax, fmaxf(fabsf(o[0]), fabsf(o[1]))), fmaxf(fabsf(o[2]), fabsf(o[3]))); }
        if (PROJ8_PN0 < 56) {
#pragma unroll
            for (int o = 1; o < 64; o <<= 1) amax = fmaxf(amax, __shfl_xor(amax, o));
            const float inv = amax > 0.f ? 127.0f / amax : 0.f; if (lane == 0) WSP(float, WS_HS)[m] = amax * (1.0f / 127.0f);
#pragma unroll
            for (int j = 0; j < 8; ++j) { const int c = 4 * lane + 256 * j; const int q0 = (int)rintf(v[j][0] * inv), q1 = (int)rintf(v[j][1] * inv), q2 = (int)rintf(v[j][2] * inv), q3 = (int)rintf(v[j][3] * inv);
                *(unsigned*)(WSP(unsigned char, WS_H8) + (size_t)m * 2048 + c) = (unsigned)(q0 & 255) | ((unsigned)(q1 & 255) << 8) | ((unsigned)(q2 & 255) << 16) | ((unsigned)q3 << 24); } }
    }
    for (int n = PROJ8_PN0 * 256 + gw; n < 14336; n += NGW) {
        const u32x4* src = (const u32x4*)(WSP(bf16_t, WS_WIN_T) + (size_t)n * 2048) + lane; float v[32]; float mx = 0.f;
#pragma unroll
        for (int j = 0; j < 4; ++j) { const u32x4 r = src[64 * j]; const unsigned rw_[4] = {r.x, r.y, r.z, r.w};
#pragma unroll
            for (int q = 0; q < 4; ++q) { v[8 * j + 2 * q] = bflo(rw_[q]); v[8 * j + 2 * q + 1] = bfhi(rw_[q]); mx = fmaxf(mx, fmaxf(fabsf(v[8 * j + 2 * q]), fabsf(v[8 * j + 2 * q + 1]))); } }
#pragma unroll
        for (int o = 1; o < 64; o <<= 1) mx = fmaxf(mx, __shfl_xor(mx, o));
        const float inv = mx > 0.f ? 127.0f / mx : 0.f; if (lane == 0) WSP(float, WS_WS)[n] = mx * (1.0f / 127.0f);
        unsigned char* dst = WSP(unsigned char, WS_WIN8) + (size_t)(n - PROJ8_PN0 * 256) * 2048;
#pragma unroll
        for (int j = 0; j < 4; ++j) { unsigned o[2];
#pragma unroll
            for (int q = 0; q < 2; ++q) { const int b0 = (int)rintf(v[8 * j + 4 * q] * inv), b1 = (int)rintf(v[8 * j + 4 * q + 1] * inv), b2 = (int)rintf(v[8 * j + 4 * q + 2] * inv), b3 = (int)rintf(v[8 * j + 4 * q + 3] * inv);
                o[q] = (unsigned)(b0 & 255) | ((unsigned)(b1 & 255) << 8) | ((unsigned)(b2 & 255) << 16) | ((unsigned)b3 << 24); }
            *(u32x2*)(dst + 8 * lane + 512 * j) = (u32x2){o[0], o[1]}; } }
    for (int i = blockIdx.x * 512 + tid; i < 4 * 2048 * 32; i += G * 512) { const int b = i >> 16, k = (i >> 5) & 2047, e = i & 31;
        WSP(float, WS_RWP)[i] = p.in[I_N2G][k] * (1.0f + MOD[b * 12288 + 4 * 2048 + k]) * p.in[I_RW][k * 32 + e]; }
    if (wave == 7 && (int)blockIdx.x < 128) { const int o = blockIdx.x, b = o >> 5, e = o & 31; float s = 0.f;
#pragma unroll
        for (int i = 0; i < 32; ++i) { const int k = lane + 64 * i; s += MOD[b * 12288 + 3 * 2048 + k] * p.in[I_RW][k * 32 + e]; }
        s = wave_sum(s); if (lane == 0) WSP(float, WS_BIASP)[o] = s + p.in[I_RB][e]; }
}
__device__ __forceinline__ void sg_load_w(const Params& p, LAS unsigned char* lds, int g) {
    LAS bf16_t* wl = (LAS bf16_t*)(lds + 69632); const float* Wg = p.in[I_SGW] + (size_t)g * 128 * 128; const int tid = threadIdx.x;
#pragma unroll
    for (int i = 0; i < 4; ++i) { const int idx = tid + 512 * i, r = idx >> 4, ch = idx & 15; const f32x4 w0 = *(const f32x4*)(Wg + r * 128 + 8 * ch), w1 = *(const f32x4*)(Wg + r * 128 + 8 * ch + 4);
        *(LAS u32x4*)(wl + r * 136 + 8 * ch) = pack8(w0, w1); }
}
__device__ __forceinline__ void sg_unit(const Params& p, LAS unsigned char* lds, int unit) {
    const int tid = threadIdx.x, lane = tid & 63, w = __builtin_amdgcn_readfirstlane(tid >> 6), fr = lane & 15, fq = lane >> 4;
    const int nb = unit >> 3, g = unit & 7, row0 = nb * 128, c0 = g * 256;
    LAS float* stat = (LAS float*)lds; LAS bf16_t* vt = (LAS bf16_t*)(lds + 1024);
    LAS const bf16_t* wl = (LAS const bf16_t*)(lds + 69632);
    const bf16_t* AV = WSP(bf16_t, WS_AV); const bf16_t* AU = WSP(bf16_t, WS_AU); bf16_t* YA = WSP(bf16_t, WS_YA);
    f32x4 lp4[4]; { const float* lp = WSP(float, WS_LNP) + (size_t)(row0 + (tid >> 2)) * 64 + 16 * (tid & 3);
#pragma unroll
        for (int i = 0; i < 4; ++i) lp4[i] = *(const f32x4*)(lp + 4 * i); }
    u32x4 raw[8];
#pragma unroll
    for (int i = 0; i < 8; ++i) { const int idx = tid + 512 * i; raw[i] = *(const u32x4*)(AV + (size_t)(row0 + (idx >> 5)) * 2048 + c0 + 8 * (idx & 31)); }
    u32x2 uu[8][2];
#pragma unroll
    for (int m = 0; m < 8; ++m)
#pragma unroll
        for (int n = 0; n < 2; ++n) uu[m][n] = *(const u32x2*)(AU + (size_t)(row0 + 16 * m + fr) * 2048 + c0 + 32 * w + 16 * n + 4 * fq);
    { float s = 0.f, q = 0.f;
#pragma unroll
      for (int i = 0; i < 4; ++i) { s += lp4[i][0] + lp4[i][2]; q += lp4[i][1] + lp4[i][3]; }
      s += __shfl_xor(s, 1); q += __shfl_xor(q, 1); s += __shfl_xor(s, 2); q += __shfl_xor(q, 2);
      if ((tid & 3) == 0) { const float mu = s * (1.0f / 2048.0f), var = q * (1.0f / 2048.0f) - mu * mu; stat[2 * (tid >> 2)] = mu; stat[2 * (tid >> 2) + 1] = rsqrtf(fmaxf(var, 0.f) + EPS); } }
    __syncthreads();
#pragma unroll
    for (int i = 0; i < 8; ++i) { const int idx = tid + 512 * i, s = idx >> 5, cc = idx & 31;
        const f32x4 g0 = *(const f32x4*)(p.in[I_LNG] + c0 + 8 * cc), g1 = *(const f32x4*)(p.in[I_LNG] + c0 + 8 * cc + 4), b0 = *(const f32x4*)(p.in[I_LNB] + c0 + 8 * cc), b1 = *(const f32x4*)(p.in[I_LNB] + c0 + 8 * cc + 4);
        const float mu = stat[2 * s], rs = stat[2 * s + 1]; const u32x4 r = raw[i];
        u32x2 o0, o1;
        o0.x = cvt_pk_bf16((bflo(r.x) - mu) * rs * g0[0] + b0[0], (bfhi(r.x) - mu) * rs * g0[1] + b0[1]); o0.y = cvt_pk_bf16((bflo(r.y) - mu) * rs * g0[2] + b0[2], (bfhi(r.y) - mu) * rs * g0[3] + b0[3]);
        o1.x = cvt_pk_bf16((bflo(r.z) - mu) * rs * g1[0] + b1[0], (bfhi(r.z) - mu) * rs * g1[1] + b1[1]); o1.y = cvt_pk_bf16((bflo(r.w) - mu) * rs * g1[2] + b1[2], (bfhi(r.w) - mu) * rs * g1[3] + b1[3]);
        *(LAS u32x2*)(vt + s * 260 + 8 * cc) = o0; *(LAS u32x2*)(vt + s * 260 + 8 * cc + 4) = o1; }
    __syncthreads();
    f32x4 acc[8][2];
#pragma unroll
    for (int m = 0; m < 8; ++m) { acc[m][0] = (f32x4){0.f, 0.f, 0.f, 0.f}; acc[m][1] = (f32x4){0.f, 0.f, 0.f, 0.f}; }
#pragma unroll
    for (int ks = 0; ks < 4; ++ks) {
        bf16x8 bfr[2];
#pragma unroll
        for (int n = 0; n < 2; ++n) bfr[n] = tr_frag(vt, 260, 32 * ks, 32 * w + 16 * n, fr, fq);
#pragma unroll
        for (int m = 0; m < 8; ++m) {
            if (m < 4 && ks >= 2) continue;
            const bf16x8 afr = *(const LAS bf16x8*)(wl + (16 * m + fr) * 136 + 32 * ks + 8 * fq);
#pragma unroll
            for (int n = 0; n < 2; ++n) acc[m][n] = __builtin_amdgcn_mfma_f32_16x16x32_bf16(bfr[n], afr, acc[m][n], 0, 0, 0);
        }
    }
#pragma unroll
    for (int m = 0; m < 8; ++m) { const float bs = p.in[I_SGB][g * 128 + 16 * m + fr];
#pragma unroll
        for (int n = 0; n < 2; ++n) { const size_t offy = (size_t)(row0 + 16 * m + fr) * 4096 + c0 + 32 * w + 16 * n + 4 * fq; const u32x2 u = uu[m][n];
            u32x2 o; o.x = cvt_pk_bf16(bflo(u.x) * (acc[m][n][0] + bs), bfhi(u.x) * (acc[m][n][1] + bs)); o.y = cvt_pk_bf16(bflo(u.y) * (acc[m][n][2] + bs), bfhi(u.y) * (acc[m][n][3] + bs));
            if (MIX8 & 1) *(unsigned*)((unsigned char*)YA + offy) = cvt4_fp8(bflo(u.x) * (acc[m][n][0] + bs), bfhi(u.x) * (acc[m][n][1] + bs), bflo(u.y) * (acc[m][n][2] + bs), bfhi(u.y) * (acc[m][n][3] + bs));
            else *(u32x2*)(YA + offy) = o; } }
    __syncthreads();
}
__device__ __forceinline__ void prep_unit(const Params& p, LAS unsigned char* lds, int unit, bool have_glr = false) {
    const int tid = threadIdx.x, lane = tid & 63, w = __builtin_amdgcn_readfirstlane(tid >> 6), fr = lane & 15, fq = lane >> 4;
    const int h = unit & 3, r0 = (unit >> 2) * 64;
    LAS float* part = (LAS float*)lds; LAS float* glr = (LAS float*)(lds + 32768); LAS float* tot = (LAS float*)(lds + 36864); LAS float* bl = (LAS float*)(lds + 37888);
    LAS bf16_t* qd = (LAS bf16_t*)(lds + 40960); LAS bf16_t* ki = (LAS bf16_t*)(lds + 40960 + 33792);
    const bf16_t* H = WSP(bf16_t, WS_H); const bf16_t* WG = WSP(bf16_t, WS_WG_T);
    { const bf16_t* Q = WSP(bf16_t, WS_Q); const bf16_t* Kk = WSP(bf16_t, WS_K);
#pragma unroll
      for (int i = 0; i < 4; ++i) { const int idx = tid + 512 * i, row = idx >> 5, ch = idx & 31; const size_t go = (size_t)(r0 + row) * 1024 + h * 256 + 8 * ch;
          const u32x4 qv = *(const u32x4*)(Q + go), kv = *(const u32x4*)(Kk + go); *(LAS u32x4*)(qd + row * 264 + 8 * ch) = qv; *(LAS u32x4*)(ki + row * 264 + 8 * ch) = kv; } }
    if (!have_glr) {
    { f32x4 ga[4];
#pragma unroll
      for (int m = 0; m < 4; ++m) ga[m] = (f32x4){0.f, 0.f, 0.f, 0.f};
#pragma unroll 2
      for (int ks = 0; ks < 8; ++ks) { const int kk = 256 * w + 32 * ks + 8 * fq; const bf16x8 bfr = *(const bf16x8*)(WG + fr * 2048 + kk);
#pragma unroll
          for (int m = 0; m < 4; ++m) { const bf16x8 afr = *(const bf16x8*)(H + (size_t)(r0 + 16 * m + fr) * 2048 + kk); ga[m] = __builtin_amdgcn_mfma_f32_16x16x32_bf16(afr, bfr, ga[m], 0, 0, 0); } }
#pragma unroll
      for (int m = 0; m < 4; ++m)
#pragma unroll
          for (int r = 0; r < 4; ++r) part[(w * 64 + 16 * m + 4 * fq + r) * 16 + fr] = ga[m][r]; }
    __syncthreads();
    for (int idx = tid; idx < 1024; idx += 512) { float s = 0.f;
#pragma unroll
        for (int ww = 0; ww < 8; ++ww) s += part[ww * 1024 + idx];
        glr[idx] = s; }
    __syncthreads();
    }
    const int kc = tid & 255, half = tid >> 8, kg = h * 256 + kc;
    float cs[32];
    { float w2[16];
#pragma unroll
      for (int j = 0; j < 16; ++j) w2[j] = p.in[I_GW2][j * 1024 + kg];
      const float gb = p.in[I_GGB][kg]; float run = 0.f;
#pragma unroll
      for (int i = 0; i < 32; ++i) { const int t = 32 * half + i; const LAS f32x4* g4 = (const LAS f32x4*)(glr + t * 16); float z = gb;
#pragma unroll
          for (int j = 0; j < 4; ++j) { const f32x4 gv = g4[j]; z += gv[0] * w2[4 * j] + gv[1] * w2[4 * j + 1] + gv[2] * w2[4 * j + 2] + gv[3] * w2[4 * j + 3]; }
          const float ls = fminf(z, 0.f) - __logf(1.0f + __expf(-fabsf(z))); run += ls * 0.0625f; cs[i] = run; }
      if (half == 0) tot[kc] = run;
      __syncthreads();
      const float off = half ? tot[kc] : 0.f;
      if (half == 1) bl[kc] = off + run;
#pragma unroll
      for (int i = 0; i < 32; ++i) cs[i] += off; }
    __syncthreads();
    const float blast = bl[kc];
    { unsigned kst[16];
#pragma unroll
      for (int i = 0; i < 32; i += 2) { float ksv[2];
#pragma unroll
          for (int ii = 0; ii < 2; ++ii) { const int t = 32 * half + i + ii; const float b = cs[i + ii];
              const float q = bf2f(qd[t * 264 + kc]), k = bf2f(ki[t * 264 + kc]); const float eb = __expf(b);
              const float qdv = q * 0.0625f * eb, kiv = k * __builtin_amdgcn_rcpf(eb); ksv[ii] = k * __expf(blast - b);
              qd[t * 264 + kc] = (bf16_t)(cvt_pk_bf16(qdv, 0.f) & 0xffffu); ki[t * 264 + kc] = (bf16_t)(cvt_pk_bf16(kiv, 0.f) & 0xffffu); }
          kst[i >> 1] = cvt_pk_bf16(ksv[0], ksv[1]); }
      u32x4* kd = (u32x4*)(WSP(bf16_t, WS_KST) + ((size_t)unit * 256 + kc) * 64 + 32 * half);
#pragma unroll
      for (int j = 0; j < 4; ++j) kd[j] = (u32x4){kst[4 * j], kst[4 * j + 1], kst[4 * j + 2], kst[4 * j + 3]};
      if (half == 0) WSP(float, WS_DC)[unit * 256 + kc] = __expf(blast); }
    __syncthreads();
    { bf16_t* QD = WSP(bf16_t, WS_QD);
#pragma unroll
      for (int i = 0; i < 4; ++i) { const int idx = tid + 512 * i, row = idx >> 5, ch = idx & 31; *(u32x4*)(QD + (size_t)(r0 + row) * 1024 + h * 256 + 8 * ch) = *(const LAS u32x4*)(qd + row * 264 + 8 * ch); } }
    { const int m = w >> 1, n0 = 2 * (w & 1); f32x4 aa[2] = {(f32x4){0.f, 0.f, 0.f, 0.f}, (f32x4){0.f, 0.f, 0.f, 0.f}};
#pragma unroll
      for (int ks = 0; ks < 8; ++ks) { const bf16x8 afr = *(const LAS bf16x8*)(qd + (16 * m + fr) * 264 + 32 * ks + 8 * fq);
#pragma unroll
          for (int nn = 0; nn < 2; ++nn) { const bf16x8 bfr = *(const LAS bf16x8*)(ki + (16 * (n0 + nn) + fr) * 264 + 32 * ks + 8 * fq);
              aa[nn] = __builtin_amdgcn_mfma_f32_16x16x32_bf16(bfr, afr, aa[nn], 0, 0, 0); } }
      bf16_t* ATT = WSP(bf16_t, WS_ATT);
#pragma unroll
      for (int nn = 0; nn < 2; ++nn) { const int t = 16 * m + fr, s0 = 16 * (n0 + nn) + 4 * fq; float v[4];
#pragma unroll
          for (int r = 0; r < 4; ++r) v[r] = (s0 + r <= t) ? aa[nn][r] : 0.f;
          u32x2 o; o.x = cvt_pk_bf16(v[0], v[1]); o.y = cvt_pk_bf16(v[2], v[3]); *(u32x2*)(ATT + ((size_t)unit * 64 + t) * 64 + s0) = o; } }
    __syncthreads();
}
struct ScanSet { u32x4 qraw[4]; u32x4 kraw[4]; u32x4 araw; u32x4 vraw; float dc; };
__device__ __forceinline__ void scan_load(ScanSet& F, const Params& p, int b, int h, int c, int vc0, int tid) {
    const int u = (b * 32 + c) * 4 + h, r0 = b * 2048 + c * 64;
    const bf16_t* QD = WSP(bf16_t, WS_QD) + (size_t)r0 * 1024 + h * 256; const bf16_t* KST = WSP(bf16_t, WS_KST) + (size_t)u * 256 * 64;
#pragma unroll
    for (int i = 0; i < 4; ++i) { const int idx = tid + 512 * i; F.qraw[i] = *(const u32x4*)(QD + (size_t)(idx >> 5) * 1024 + 8 * (idx & 31)); F.kraw[i] = *(const u32x4*)(KST + (size_t)idx * 8); }
    F.araw = *(const u32x4*)(WSP(bf16_t, WS_ATT) + ((size_t)u * 64 + (tid >> 3)) * 64 + 8 * (tid & 7));
    F.vraw = *(const u32x4*)(WSP(bf16_t, WS_V) + (size_t)(r0 + (tid >> 3)) * 2048 + vc0 + 8 * (tid & 7));
    F.dc = WSP(float, WS_DC)[u * 256 + (tid & 255)];
}
__device__ __forceinline__ void scan_step(ScanSet& cur, int cnext, f32x4 (&sS)[2][4], const Params& p, LAS unsigned char* lds, int b, int h, int c, int vc0, int w, int fr, int fq, int tid) {
    LAS bf16_t* st = (LAS bf16_t*)lds;
    LAS bf16_t* vt = (LAS bf16_t*)(lds + 33792);
    LAS bf16_t* qd = (LAS bf16_t*)(lds + 43008);
    LAS bf16_t* at = (LAS bf16_t*)(lds + 76800);
    LAS bf16_t* kt = (LAS bf16_t*)(lds + 86016);
    LAS float* dcs = (LAS float*)(lds + 122880);
    const int rt = w >> 1, cp = w & 1;
#pragma unroll
    for (int i = 0; i < 2; ++i)
#pragma unroll
        for (int n = 0; n < 4; ++n) { u32x2 o; o.x = cvt_pk_bf16(sS[i][n][0], sS[i][n][1]); o.y = cvt_pk_bf16(sS[i][n][2], sS[i][n][3]);
            *(LAS u32x2*)(st + (16 * n + fr) * 264 + 32 * w + 16 * i + 4 * fq) = o; }
    *(LAS u32x4*)(vt + (tid >> 3) * 72 + 8 * (tid & 7)) = cur.vraw;
#pragma unroll
    for (int i = 0; i < 4; ++i) { const int idx = tid + 512 * i; *(LAS u32x4*)(qd + (idx >> 5) * 264 + 8 * (idx & 31)) = cur.qraw[i]; *(LAS u32x4*)(kt + (idx >> 3) * 72 + 8 * (idx & 7)) = cur.kraw[i]; }
    *(LAS u32x4*)(at + (tid >> 3) * 72 + 8 * (tid & 7)) = cur.araw;
    if (tid < 256) dcs[tid] = cur.dc;
    scan_load(cur, p, b, h, cnext, vc0, tid);
    __syncthreads();
    bf16_t* O = WSP(bf16_t, WS_O);
    bf16x8 afr[2];
#pragma unroll
    for (int ks = 0; ks < 2; ++ks) afr[ks] = *(const LAS bf16x8*)(at + (16 * rt + fr) * 72 + 32 * ks + 8 * fq);
    f32x4 dcv[2]; dcv[0] = *(const LAS f32x4*)(dcs + 32 * w + 4 * fq); dcv[1] = *(const LAS f32x4*)(dcs + 32 * w + 16 + 4 * fq);
    bf16x8 kf[2][2];
#pragma unroll
    for (int i = 0; i < 2; ++i)
#pragma unroll
        for (int ks = 0; ks < 2; ++ks) kf[i][ks] = *(const LAS bf16x8*)(kt + (32 * w + 16 * i + fr) * 72 + 32 * ks + 8 * fq);
#pragma unroll
    for (int n = 0; n < 4; ++n) { bf16x8 vf[2];
#pragma unroll
        for (int ks = 0; ks < 2; ++ks) vf[ks] = tr_frag(vt, 72, 32 * ks, 16 * n, fr, fq);
        if ((n >> 1) == cp) { const int ct = n;
            f32x4 ao = (f32x4){0.f, 0.f, 0.f, 0.f};
#pragma unroll
            for (int ks = 0; ks < 8; ++ks) { const bf16x8 sfr = *(const LAS bf16x8*)(st + (16 * ct + fr) * 264 + 32 * ks + 8 * fq), qfr = *(const LAS bf16x8*)(qd + (16 * rt + fr) * 264 + 32 * ks + 8 * fq); ao = __builtin_amdgcn_mfma_f32_16x16x32_bf16(sfr, qfr, ao, 0, 0, 0); }
#pragma unroll
            for (int ks = 0; ks < 2; ++ks) ao = __builtin_amdgcn_mfma_f32_16x16x32_bf16(vf[ks], afr[ks], ao, 0, 0, 0);
            u32x2 o; o.x = cvt_pk_bf16(ao[0], ao[1]); o.y = cvt_pk_bf16(ao[2], ao[3]);
            *(u32x2*)(O + (size_t)(b * 2048 + c * 64 + 16 * rt + fr) * 2048 + vc0 + 16 * ct + 4 * fq) = o; }
#pragma unroll
        for (int i = 0; i < 2; ++i) { sS[i][n] = sS[i][n] * dcv[i];
#pragma unroll
            for (int ks = 0; ks < 2; ++ks) sS[i][n] = __builtin_amdgcn_mfma_f32_16x16x32_bf16(kf[i][ks], vf[ks], sS[i][n], 0, 0, 0); } }
    __syncthreads();
}
__device__ __forceinline__ void scan_unit(const Params& p, LAS unsigned char* lds, int unit) {
    const int tid = threadIdx.x, lane = tid & 63, w = __builtin_amdgcn_readfirstlane(tid >> 6), fr = lane & 15, fq = lane >> 4;
    const int sl = unit & 7, h = (unit >> 3) & 3, b = unit >> 5, vc0 = h * 512 + sl * 64;
    f32x4 sS[2][4];
#pragma unroll
    for (int i = 0; i < 2; ++i)
#pragma unroll
        for (int n = 0; n < 4; ++n) sS[i][n] = (f32x4){0.f, 0.f, 0.f, 0.f};
    ScanSet A, B;
    scan_load(A, p, b, h, 0, vc0, tid); scan_load(B, p, b, h, 1, vc0, tid);
#pragma unroll 1
    for (int c = 0; c < 32; c += 2) {
        scan_step(A, c + 2 < 32 ? c + 2 : 31, sS, p, lds, b, h, c, vc0, w, fr, fq, tid);
        scan_step(B, c + 3 < 32 ? c + 3 : 31, sS, p, lds, b, h, c + 1, vc0, w, fr, fq, tid);
    }
}
__device__ __forceinline__ void p5_yb(const Params& p) {
    const int tid = threadIdx.x, lane = tid & 63, wave = tid >> 6, gw = blockIdx.x * NWAVES + wave, NGW = gridDim.x * NWAVES;
    const f32x4 g0 = *(const f32x4*)(p.in[I_GNG] + 8 * lane), g1 = *(const f32x4*)(p.in[I_GNG] + 8 * lane + 4);
    for (int m = gw; m < NTOK; m += NGW) {
#pragma unroll
        for (int hh = 0; hh < 4; ++hh) { const size_t off = (size_t)m * 2048 + hh * 512 + 8 * lane;
            const u32x4 o = *(const u32x4*)(WSP(bf16_t, WS_O) + off), r = *(const u32x4*)(WSP(bf16_t, WS_R) + off);
            float v[8] = {bflo(o.x), bfhi(o.x), bflo(o.y), bfhi(o.y), bflo(o.z), bfhi(o.z), bflo(o.w), bfhi(o.w)};
            float s = 0.f;
#pragma unroll
            for (int j = 0; j < 8; ++j) s += v[j] * v[j];
            const float rstd = rsqrtf(wave_sum(s) * (1.0f / 512.0f) + EPS);
            const float rr[8] = {bflo(r.x), bfhi(r.x), bflo(r.y), bfhi(r.y), bflo(r.z), bfhi(r.z), bflo(r.w), bfhi(r.w)};
            f32x4 y0, y1;
#pragma unroll
            for (int j = 0; j < 4; ++j) { y0[j] = v[j] * rstd * g0[j] * rr[j]; y1[j] = v[4 + j] * rstd * g1[j] * rr[4 + j]; }
            if (MIX8 & 1) { u32x2 w8; w8.x = cvt4_fp8(y0[0], y0[1], y0[2], y0[3]); w8.y = cvt4_fp8(y1[0], y1[1], y1[2], y1[3]); *(u32x2*)(WSP(unsigned char, WS_YA) + (size_t)m * 4096 + 2048 + hh * 512 + 8 * lane) = w8; }
            else *(u32x4*)(WSP(bf16_t, WS_YA) + (size_t)m * 4096 + 2048 + hh * 512 + 8 * lane) = pack8(y0, y1); }
    }
}
__device__ __forceinline__ void router_item(const Params& p, LAS unsigned char* lds, int item) {
    const int tid = threadIdx.x, lane = tid & 63, w = __builtin_amdgcn_readfirstlane(tid >> 6);
    const int R0 = item * 32, b = R0 >> 11;
    LAS float* pl = (LAS float*)lds; LAS float* sq = (LAS float*)(lds + 32768); LAS float* lg = (LAS float*)(lds + 33792); LAS float* rs = (LAS float*)(lds + 38400);
    LAS int* lcnt = (LAS int*)(lds + 38656); LAS int* lbase = (LAS int*)(lds + 38912);
    if (tid < 32) lcnt[tid] = 0;
    const float* X1 = WSP(float, WS_X1);
    { f32x16 acc;
#pragma unroll
      for (int i = 0; i < 16; ++i) acc[i] = 0.f;
      float ssq = 0.f; const int row = lane & 31, hi = lane >> 5;
      const float* xr = X1 + (size_t)(R0 + row) * 2048 + 256 * w + 4 * hi;
      const float* br = WSP(float, WS_RWP) + (size_t)b * 65536 + (size_t)(256 * w + 4 * hi) * 32 + row;
#pragma unroll 8
      for (int kb = 0; kb < 256; kb += 8) { const f32x4 va = *(const f32x4*)(xr + kb); ssq += (va[0] * va[0] + va[1] * va[1]) + (va[2] * va[2] + va[3] * va[3]);
#pragma unroll
          for (int j = 0; j < 4; ++j) acc = __builtin_amdgcn_mfma_f32_32x32x2f32(va[j], br[(kb + j) * 32], acc, 0, 0, 0); }
      ssq += __shfl_xor(ssq, 32);
      if (lane < 32) sq[w * 32 + lane] = ssq;
#pragma unroll
      for (int r = 0; r < 16; ++r) pl[(w * 32 + (r & 3) + 8 * (r >> 2) + 4 * hi) * 32 + row] = acc[r]; }
    __syncthreads();
#pragma unroll
    for (int q = 0; q < 2; ++q) { const int idx = tid + 512 * q, r = idx >> 5, e = idx & 31; float s = 0.f, ss = 0.f;
#pragma unroll
        for (int ww = 0; ww < 8; ++ww) { s += pl[ww * 1024 + idx]; ss += sq[ww * 32 + r]; }
        const float rstd = rsqrtf(ss * (1.0f / 2048.0f) + EPS); lg[r * 33 + e] = s * rstd + WSP(float, WS_BIASP)[b * 32 + e]; if (e == 0) rs[r] = rstd; }
    __syncthreads();
    const float* MOD = WSP(float, WS_MOD) + b * 12288;
    if (w == 0) {
        int ek[4] = {0, 0, 0, 0}, rk[4] = {0, 0, 0, 0}; float wk[4] = {0.f, 0.f, 0.f, 0.f};
        if (tid < 32) { unsigned taken = 0u; float lv[4];
#pragma unroll
            for (int k = 0; k < 4; ++k) { float best = -3.0e38f; int bi = 0;
                for (int e = 0; e < 32; ++e) { const float x = lg[tid * 33 + e]; if (!((taken >> e) & 1u) && x > best) { best = x; bi = e; } }
                taken |= 1u << bi; ek[k] = bi; lv[k] = best; }
            float sum = 0.f;
#pragma unroll
            for (int k = 0; k < 4; ++k) { wk[k] = expf(lv[k] - lv[0]); sum += wk[k]; }
#pragma unroll
            for (int k = 0; k < 4; ++k) { wk[k] /= sum; rk[k] = __hip_atomic_fetch_add(&lcnt[ek[k]], 1, __ATOMIC_RELAXED, __HIP_MEMORY_SCOPE_WORKGROUP); } }
        __builtin_amdgcn_fence(__ATOMIC_SEQ_CST, "wavefront"); LDS_WAIT(); asm volatile("" ::: "memory");
        if (tid < 32) { const int c = lcnt[tid]; lbase[tid] = c ? (int)__hip_atomic_fetch_add((unsigned*)WSP(unsigned, WS_CTL) + CW_CNT + tid, (unsigned)c, __ATOMIC_RELAXED, __HIP_MEMORY_SCOPE_AGENT) : 0; }
        __builtin_amdgcn_fence(__ATOMIC_SEQ_CST, "wavefront"); LDS_WAIT(); asm volatile("" ::: "memory");
        if (tid < 32) {
#pragma unroll
            for (int k = 0; k < 4; ++k) { const int pos = lbase[ek[k]] + rk[k], slot = (R0 + tid) * 4 + k; WSP(int, WS_LIST)[ek[k] * 8192 + pos] = slot; WSP(float, WS_TOPW)[slot] = wk[k]; } }
    } else {
#pragma unroll
        for (int rr = 0; rr < 5; ++rr) { if (rr == 4 && w > 4) break; const int r = rr < 4 ? 4 * (w - 1) + rr : 27 + w; const float rstd = rs[r]; const size_t ro = (size_t)(R0 + r) * 2048;
#pragma unroll
            for (int j = 0; j < 4; ++j) { const int c = 8 * lane + 512 * j; f32x4 o[2];
#pragma unroll
                for (int q = 0; q < 2; ++q) { const f32x4 x = *(const f32x4*)(X1 + ro + c + 4 * q), g = *(const f32x4*)(p.in[I_N2G] + c + 4 * q), sc = *(const f32x4*)(MOD + 4 * 2048 + c + 4 * q), sh = *(const f32x4*)(MOD + 3 * 2048 + c + 4 * q);
                    o[q] = x * rstd * g * (sc + 1.0f) + sh; }
                u32x2 w8; w8.x = cvt4_fp8(o[0][0], o[0][1], o[0][2], o[0][3]); w8.y = cvt4_fp8(o[1][0], o[1][1], o[1][2], o[1][3]); *(u32x2*)(WSP(unsigned char, WS_H) + ro + c) = w8; } }
    }
    __syncthreads();
}
__device__ __forceinline__ int moe_tables(const Params& p, LAS int* tab) {
    const int tid = threadIdx.x;
    if (tid < 32) tab[tid] = (int)__hip_atomic_load((unsigned*)WSP(unsigned, WS_CTL) + CW_CNT + tid, __ATOMIC_RELAXED, __HIP_MEMORY_SCOPE_AGENT);
    __syncthreads();
    if (tid < 32) { const int n = (tab[tid] + 255) >> 8; int incl = n;
#pragma unroll
        for (int o = 1; o < 32; o <<= 1) { const int t = __shfl_up(incl, o); if (tid >= o) incl += t; }
        const int a = incl - n; tab[32 + tid] = a; if (tid == 31) tab[64] = incl;
        for (int j = 0; j < n; ++j) tab[72 + a + j] = tid; }
    __syncthreads();
    return tab[64];
}
__device__ __forceinline__ void p11_final(const Params& p) {
    const int tid = threadIdx.x, lane = tid & 63, wave = tid >> 6, gw = blockIdx.x * NWAVES + wave, NGW = gridDim.x * NWAVES;
    const float* X1 = WSP(float, WS_X1); const bf16_t* Y = WSP(bf16_t, WS_Y); const float* TW = WSP(float, WS_TOPW);
    const int rpw = (NTOK + NGW - 1) / NGW;
    f32x4 fg[4][2], gt[4][2]; int bprev = -1;
#pragma unroll
    for (int j = 0; j < 4; ++j)
#pragma unroll
        for (int q = 0; q < 2; ++q) fg[j][q] = *(const f32x4*)(p.in[I_FG] + 8 * lane + 512 * j + 4 * q);
    for (int i = 0; i < rpw; ++i) { const int m = gw * rpw + i; if (m >= NTOK) break;
        const int b = m >> 11;
        if (b != bprev) { bprev = b; const float* gt2 = WSP(float, WS_MOD) + b * 12288 + 5 * 2048;
#pragma unroll
            for (int j = 0; j < 4; ++j)
#pragma unroll
                for (int q = 0; q < 2; ++q) gt[j][q] = *(const f32x4*)(gt2 + 8 * lane + 512 * j + 4 * q); }
        const f32x4 wk = *(const f32x4*)(TW + 4 * m);
        f32x4 x2[4][2]; float s = 0.f;
#pragma unroll
        for (int j = 0; j < 4; ++j) { const int c = 8 * lane + 512 * j; f32x4 mo[2] = {(f32x4){0.f, 0.f, 0.f, 0.f}, (f32x4){0.f, 0.f, 0.f, 0.f}};
#pragma unroll
            for (int k = 0; k < 4; ++k) { const u32x4 y = *(const u32x4*)(Y + ((size_t)m * 4 + k) * 2048 + c); const float wv = wk[k];
                mo[0][0] += wv * bflo(y.x); mo[0][1] += wv * bfhi(y.x); mo[0][2] += wv * bflo(y.y); mo[0][3] += wv * bfhi(y.y);
                mo[1][0] += wv * bflo(y.z); mo[1][1] += wv * bfhi(y.z); mo[1][2] += wv * bflo(y.w); mo[1][3] += wv * bfhi(y.w); }
#pragma unroll
            for (int q = 0; q < 2; ++q) { const f32x4 x = *(const f32x4*)((DBG_MODE == 1 ? p.in[I_X] : X1) + (size_t)m * 2048 + c + 4 * q); const f32x4 v = (DBG_MODE == 0) ? x + gt[j][q] * mo[q] : x; x2[j][q] = v;
                s += (v[0] * v[0] + v[1] * v[1]) + (v[2] * v[2] + v[3] * v[3]); } }
        const float rstd = rsqrtf(wave_sum(s) * (1.0f / 2048.0f) + EPS);
#pragma unroll
        for (int j = 0; j < 4; ++j)
#pragma unroll
            for (int q = 0; q < 2; ++q) { const int c = 8 * lane + 512 * j + 4 * q; *(f32x4*)(p.out + (size_t)m * 2048 + c) = x2[j][q] * rstd * fg[j][q]; }
    }
}


__device__ __forceinline__ void dbg_out(const Params& p, int mode) {
    const size_t n = (size_t)NTOK * 2048;
    for (size_t i = (size_t)blockIdx.x * 512 + threadIdx.x; i < n; i += (size_t)gridDim.x * 512) {
        const size_t m = i >> 11, c = i & 2047; float v = 0.f;
        if (mode == 3) v = bf2f(WSP(bf16_t, WS_H)[i]) + WSP(float, WS_MOD)[i % 49152] + WSP(float, WS_RWP)[i % 262144] + bf2f(WSP(bf16_t, WS_WIN_T)[i]) + bf2f(WSP(bf16_t, WS_WA_T)[i % 4194304]) + bf2f(WSP(bf16_t, WS_WG_T)[i % 32768]);
        if (mode == 4) v = bf2f(WSP(bf16_t, WS_AU)[i]) + bf2f(WSP(bf16_t, WS_AV)[i]) + bf2f(WSP(bf16_t, WS_V)[i]) + bf2f(WSP(bf16_t, WS_R)[i]) + bf2f(WSP(bf16_t, WS_GA)[i]) + bf2f(WSP(bf16_t, WS_GB)[i]) + bf2f(WSP(bf16_t, WS_Q)[m * 1024 + (c & 1023)]) + bf2f(WSP(bf16_t, WS_K)[m * 1024 + (c & 1023)]) + WSP(float, WS_LNP)[i % 524288];
        if (mode == 5) v = bf2f(WSP(bf16_t, WS_YA)[i]);
        if (mode == 6) v = bf2f(WSP(bf16_t, WS_QD)[i % 8388608]) + bf2f(WSP(bf16_t, WS_KST)[i % 8388608]) + bf2f(WSP(bf16_t, WS_ATT)[i % 2097152]) + WSP(float, WS_DC)[i % 131072];
        if (mode == 7) v = bf2f(WSP(bf16_t, WS_O)[i]);
        if (mode == 8) v = bf2f(WSP(bf16_t, WS_YB)[i]) + WSP(float, WS_M1)[i];
        if (mode == 9) v = bf2f(WSP(bf16_t, WS_MERGED)[i]);
        p.out[i] = v;
    }
}

constexpr int PER_PHASE = 12;
constexpr int N_LAUNCHES = MK_N_LAUNCHES;
__global__ void __launch_bounds__(NWAVES * 64, 2) fwd_kernel(Params p) {
    extern __shared__ __attribute__((aligned(16))) unsigned char lds_raw[];
    LAS unsigned char* lds = (LAS unsigned char*)lds_raw;
    const int tid = threadIdx.x, G = gridDim.x;
    for (int u = tid; u < (TAB_OFF - LDSCTL_OFF) / 4; u += NWAVES * 64) ((LAS unsigned*)(lds + LDSCTL_OFF))[u] = 0u;
    __syncthreads();
    unsigned* ctl = WSP(unsigned, WS_CTL);
    XcdBarrier bar; bar.bar = ctl + CW_BAR; bar.x = 0; bar.st = nullptr;
    if (N_LAUNCHES == 1) bar = xcd_barrier_post(ctl + CW_BAR, (volatile LAS unsigned*)(lds + MISC_OFF) + 8);
    const int lo = p.ph_lo, hi = p.ph_hi;
#define IN(k) (lo <= (k) && (k) < hi)
#define SEAM(k) do { if (IN(k) && IN((k) + 1)) xcd_barrier(bar); } while (0)

    if (IN(0)) { p0_prologue(p, lds); }
    SEAM(0);
    if (IN(1)) { p1_norm1(p); }
    SEAM(1);
    if (IN(2)) {
        if (PROJ8_PN0 > 0) { DenseSched S; S.o.init(NTOK / 256, PROJ8_PN0, G, blockIdx.x); S.A = (const char*)WSP(bf16_t, WS_H); S.Bt = (const char*)WSP(bf16_t, WS_WIN_T); S.K = 2048;
            EpiProj E{p.ws, false}; pg8::gemm_phase<EpiProj, DenseSched>(lds, S, E, 2048); }
        if (PROJ8_PN0 < 56) { DenseSched8 S; S.o.init(NTOK / 256, 56 - PROJ8_PN0, G, blockIdx.x); S.A = (const char*)WSP(unsigned char, WS_H8); S.Bt = (const char*)WSP(unsigned char, WS_WIN8); S.K = 2048; S.pn0 = PROJ8_PN0;
            EpiProj E{p.ws, true}; pg8::gemm_phase<EpiProj, DenseSched8>(lds, S, E, 2048); }
    }
    SEAM(2);
    if (IN(3)) {
        if (G == 256) { const int x = blockIdx.x & 7, sidx = blockIdx.x >> 3;
            for (int i = 0; i < 2; ++i) { const int j = sidx * 2 + i; prep_unit(p, lds, ((((x >> 1) * 32 + (j >> 1)) << 2) | (2 * (x & 1) + (j & 1))), i == 1); } }
        else for (int u = blockIdx.x; u < 512; u += G) prep_unit(p, lds, u);
    }
    SEAM(3);
    if (IN(4)) {
        const int half = G >> 1, x = blockIdx.x & 7, sidx = blockIdx.x >> 3;
        if (G == 256) {
            if (!(sidx & 1)) { const int s16 = sidx >> 1; for (int r_ = 0; r_ < REP_SCAN; ++r_) scan_unit(p, lds, ((x * 2 + (s16 >> 3)) << 3) | (s16 & 7)); }
            else { const int j = (sidx >> 1) * 8 + x; sg_load_w(p, lds, j & 7); for (int r_ = 0; r_ < REP_SG; ++r_) for (int u = j; u < 512; u += half) sg_unit(p, lds, u);
                const int wv = __builtin_amdgcn_readfirstlane(tid >> 6); xp_run<false>(p, lds + wv * 8192, j * 8 + wv, 1024, XSPLIT / 1024, tid & 63); }
        } else { for (int u = blockIdx.x; u < 128; u += G) scan_unit(p, lds, u); for (int u = blockIdx.x; u < 512; u += G) { __syncthreads(); sg_load_w(p, lds, u & 7); sg_unit(p, lds, u); } }
    }
    SEAM(4);
    if (IN(5)) { p5_yb(p); }
    SEAM(5);
    if (IN(6)) {
        SchedM S; S.o.init(NTOK / 256, 8, G, blockIdx.x); S.A = (const char*)WSP(bf16_t, WS_YA); S.Bt = (const char*)WSP(bf16_t, WS_WA_T); S.K = 4096;
        EpiMerge E{WSP(bf16_t, WS_GA), WSP(bf16_t, WS_GB), WSP(bf16_t, WS_MERGED)};
        pg8::gemm_phase<EpiMerge, SchedM>(lds, S, E, 4096);
    }
    SEAM(6);
    if (IN(7)) {
        SchedO S; S.o.init(NTOK / 256, 8, G, blockIdx.x); S.A = (const char*)WSP(bf16_t, WS_MERGED); S.Bt = (const char*)WSP(bf16_t, WS_WOUT_T); S.K = 2048;
        EpiOut E{p.in[I_X], WSP(float, WS_MOD), WSP(float, WS_X1)};
        pg8::gemm_phase<EpiOut, SchedO>(lds, S, E, 2048);
    }
    SEAM(7);
    if (IN(8)) { for (int it = blockIdx.x; it < NTOK / 32; it += G) router_item(p, lds, it); }
    SEAM(8);
    if (IN(9)) {
        LAS int* tab = (LAS int*)(lds + TAB_OFF); LAS unsigned* goff = (LAS unsigned*)(lds + TAB_OFF + 1024);
        const int NT = moe_tables(p, tab);
        const int units = NT * 16, R = (units + G - 1) / G, need = (G == 256) ? (((units + R - 1) / R + pg8::NXCD - 1) / pg8::NXCD) * pg8::NXCD : G, nfree = G - need;
        const int wv9 = __builtin_amdgcn_readfirstlane(tid >> 6);
        if (G == 256) {
            const int quota = nfree * NWAVES * ((43 * R) / 10), nq = quota < DSPLIT_ITEMS ? quota : DSPLIT_ITEMS;
            const bool conv = (int)blockIdx.x >= need;
            const int first = conv ? ((int)blockIdx.x - need) * NWAVES + wv9 : nq + (int)blockIdx.x * NWAVES + wv9, stride = (conv ? nfree : need) * NWAVES, lim = conv ? nq : DSPLIT_ITEMS;
            xp_run<true>(p, lds + wv9 * 8192, first, stride, first < lim ? (lim - first + stride - 1) / stride : 0, tid & 63);
            __syncthreads(); }
        const int Geff = need;
        if ((int)blockIdx.x < need) {
        Moe1Sched S; S.o.init(NT, 16, Geff, blockIdx.x); S.A = (const char*)WSP(bf16_t, WS_H); S.W = (const char*)WSP(bf16_t, WS_WGU_T); S.tab = tab; S.goff = goff;
        { int tk[5];
#pragma unroll
          for (int q = 0; q < 5; ++q) { const int idx = tid + 512 * q, i = idx >> 8, r = idx & 255; int pm, pn; tk[q] = -1;
              if (S.o.idx(i, pm, pn)) { const int e = tab[72 + pm], pos = (pm - tab[32 + e]) * 256 + r; tk[q] = pos < tab[e] ? (WSP(int, WS_LIST)[e * 8192 + pos] >> 2) : 0; } }
#pragma unroll
          for (int q = 0; q < 5; ++q) if (tk[q] >= 0) goff[tid + 512 * q] = (unsigned)tk[q] * 2048u; }
        __syncthreads();
        EpiAct E{p.in[I_EBG], p.in[I_EBU], WSP(bf16_t, WS_ACT)};
        pg8::gemm_phase<EpiAct, Moe1Sched>(lds, S, E, 2048);
        }
    }
    SEAM(9);
    if (IN(10)) {
        LAS int* tab = (LAS int*)(lds + TAB_OFF);
        const int NT = moe_tables(p, tab);
        Moe2Sched S; S.o.init(NT, 8, G, blockIdx.x); S.A = (const char*)WSP(bf16_t, WS_ACT); S.W = (const char*)WSP(bf16_t, WS_WDN_T); S.tab = tab;
        EpiDown E{p.in[I_EBD], WSP(bf16_t, WS_Y), WSP(int, WS_LIST), tab};
        pg8::gemm_phase<EpiDown, Moe2Sched>(lds, S, E, 2048);
    }
    SEAM(10);
    if (IN(11)) { if (DBG_MODE >= 3) dbg_out(p, DBG_MODE); else p11_final(p); }
#undef IN
#undef SEAM
}

extern "C" void kernel_launch(void* const* d_in, const int* in_sizes, int n_in, void* d_out, int out_size, void* d_ws, size_t ws_size, hipStream_t stream) {
    static int grid = 0;
    if (grid == 0) {
        if (n_in != 26 || out_size != NTOK * DM || ws_size < WS_END) { fprintf(stderr, "kernel_launch: unexpected shapes (n_in %d, out %d, ws %zu); nothing launched\n", n_in, out_size, ws_size); grid = -1; return; }
        int dev = 0, cus = 0, per_cu = 0;
        if (hipGetDevice(&dev) != hipSuccess || hipDeviceGetAttribute(&cus, hipDeviceAttributeMultiprocessorCount, dev) != hipSuccess) { grid = -1; return; }
        if (hipFuncSetAttribute((const void*)fwd_kernel, hipFuncAttributeMaxDynamicSharedMemorySize, LDS_BYTES) != hipSuccess) { fprintf(stderr, "kernel_launch: hipFuncSetAttribute failed\n"); grid = -1; return; }
        if (hipOccupancyMaxActiveBlocksPerMultiprocessor(&per_cu, (const void*)fwd_kernel, NWAVES * 64, LDS_BYTES) != hipSuccess || per_cu < 1) { fprintf(stderr, "kernel_launch: occupancy query says %d blocks per CU\n", per_cu); }
        (void)hipGetLastError();
        grid = cus;
    }
    if (grid < 0) return;
    if (hipMemsetAsync((char*)d_ws + WS_CTL, 0, CTL_ZERO_BYTES, stream) != hipSuccess) return;
    Params a{};
    for (int i = 0; i < 26; ++i) a.in[i] = (const float*)d_in[i];
    a.out = (float*)d_out; a.ws = (unsigned char*)d_ws;
    for (int li = 0; li < N_LAUNCHES; ++li) {
        if (DBG_MODE == 1 && li != 11) continue;
        if (DBG_MODE == 2 && li >= 8 && li != 11) continue;
        { const int lastph[10] = {11, 11, 7, 1, 2, 3, 3, 4, 5, 6}; if (DBG_MODE >= 3 && li > lastph[DBG_MODE] && li != 11) continue; }
        a.ph_lo = (N_LAUNCHES == 1) ? 0 : li; a.ph_hi = (N_LAUNCHES == 1) ? PER_PHASE : li + 1; a.li = li; a.pad = 0;
        for (int rep_ = 0; rep_ <= ((REPEAT_MASK >> li) & 1); ++rep_) {
            if (rep_ && li == 8) (void)hipMemsetAsync((char*)d_ws + WS_CTL + CW_CNT * 4, 0, 128, stream);
        hipLaunchKernelGGL(fwd_kernel, dim3(grid), dim3(NWAVES * 64), LDS_BYTES, stream, a);
        }
        const hipError_t le = hipPeekAtLastError();
        if (le != hipSuccess) { fprintf(stderr, "kernel_launch: launch %d failed: %s\n", li, hipGetErrorName(le)); break; }
    }
}
```
